# Optimizing an MI355X kernel written in HIP

```python
import math
import numpy as np
import jax
import jax.numpy as jnp
from jax import lax

D_MODEL = 1024
BATCH = 8
SEQ = 4096
DEPTH = 2

CTX_LEN = 256
GRID_W = 64
N_EVEN = (DEPTH + 1) // 2
N_ODD = DEPTH // 2
N_MOD = 9
D_FF = 2816
EPS = 1e-6

DA_HEADS = 4
DA_HD = 64
DA_VD = 2 * DA_HD
ML_HEADS = 4
ML_QK = 64
ML_V = 128
ML_CONV = 3
GLA_HEADS = 4
GLA_K = 128
GLA_V = 256
GLA_RANK = 16
GLA_TAU = 16.0

CHUNK = 64
Q_BLOCK = 128
ROPE_BASE = 10000.0
ROPE_AXIS = DA_HD // 2

EVEN_SPLITS = (DA_HEADS * 2 * DA_HD, DA_HEADS * 2 * DA_HD, DA_HEADS * DA_VD,
               2 * ML_HEADS * ML_QK, ML_HEADS * ML_V, ML_HEADS * ML_V, 4 * ML_HEADS)
EVEN_IN = sum(EVEN_SPLITS)
ODD_SPLITS = (GLA_HEADS * GLA_K, GLA_HEADS * GLA_K, GLA_HEADS * GLA_V, GLA_HEADS * GLA_V, 2 * GLA_RANK)
ODD_IN = sum(ODD_SPLITS)

kernel_name = "hybrid_diffattn_mlstm_gla_macaron_prefix"


def _split(p, sizes):
    idx = np.cumsum(sizes)[:-1].tolist()
    return jnp.split(p, idx, axis=-1)


def rms_norm(x, g):
    xf = x.astype(jnp.float32)
    y = xf * lax.rsqrt(jnp.mean(xf * xf, axis=-1, keepdims=True) + EPS)
    return y.astype(x.dtype) * g


def ada_norm(x, g, shift, scale):
    return rms_norm(x, g) * (1.0 + scale) + shift


def swiglu(h, w_in, w_out):
    a, b = jnp.split(h @ w_in, 2, axis=-1)
    return (jax.nn.silu(a) * b) @ w_out


def axial_rope_tables(rows, dtype):
    row = jnp.repeat(jnp.arange(rows), GRID_W).astype(jnp.float32)
    col = (jnp.arange(rows * GRID_W) % GRID_W).astype(jnp.float32)
    inv = ROPE_BASE ** (-jnp.arange(ROPE_AXIS // 2, dtype=jnp.float32) * 2.0 / ROPE_AXIS)
    ar = row[:, None] * inv
    ac = col[:, None] * inv
    return (jnp.cos(ar).astype(dtype), jnp.sin(ar).astype(dtype),
            jnp.cos(ac).astype(dtype), jnp.sin(ac).astype(dtype))


def _rope_1d(x, cos, sin):
    cos = cos[None, :, None, None, :]
    sin = sin[None, :, None, None, :]
    x1, x2 = jnp.split(x, 2, axis=-1)
    return jnp.concatenate([x1 * cos - x2 * sin, x2 * cos + x1 * sin], axis=-1)


def rope_2d(x, rope):
    cr, sr, cc, sc = rope
    xr, xc = jnp.split(x, 2, axis=-1)
    return jnp.concatenate([_rope_1d(xr, cr, sr), _rope_1d(xc, cc, sc)], axis=-1)


def diff_softmax_core(q, k, v, lam):
    s = jnp.einsum('bqhcd,bkhcd->bhcqk', q.astype(jnp.float32), k.astype(jnp.float32)) * (DA_HD ** -0.5)
    p = jax.nn.softmax(s, axis=-1)
    w = p[:, :, 0] - lam * p[:, :, 1]
    return jnp.einsum('bhqk,bkhe->bqhe', w, v.astype(jnp.float32))


def diff_attn_latent(q, k, v, lam):
    b, t, h, _, d = q.shape
    nb = t // Q_BLOCK
    qb = jnp.moveaxis(q.reshape(b, nb, Q_BLOCK, h, 2, d), 1, 0)
    out = lax.map(lambda qq: diff_softmax_core(qq, k, v, lam), qb)
    return jnp.moveaxis(out, 0, 1).reshape(b, t, h, -1)


def dw_conv(x, w, bias):
    ch = x.shape[-1]
    pad = ML_CONV // 2
    y = lax.conv_general_dilated(x, w[:, None, :].astype(x.dtype), window_strides=(1,),
                                 padding=((pad, pad),), dimension_numbers=('NWC', 'WIO', 'NWC'),
                                 feature_group_count=ch)
    return y + bias


def to_chunks(a):
    b, s, h = a.shape[:3]
    rest = a.shape[3:]
    a = a.reshape((b, s // CHUNK, CHUNK, h) + rest)
    return a.transpose((1, 0, 3, 2) + tuple(range(4, a.ndim)))


def from_chunks(y):
    nc, b, h, l = y.shape[:4]
    rest = y.shape[4:]
    y = y.transpose((1, 0, 3, 2) + tuple(range(4, y.ndim)))
    return y.reshape((b, nc * l, h) + rest)


def mlstm_scan(q, k, v, ig, lf, state):
    xs = tuple(to_chunks(a.astype(jnp.float32)) for a in (q, k, v, ig, lf))
    tril = jnp.tril(jnp.ones((CHUNK, CHUNK), dtype=bool))

    def step(carry, inp):
        cmat, nvec, m = carry
        qc, kc, vc, ic, fc = inp
        bcum = jnp.cumsum(fc, axis=-1)
        dmat = jnp.where(tril, bcum[..., :, None] - bcum[..., None, :] + ic[..., None, :], -jnp.inf)
        m_inter = bcum + m[..., None]
        m_t = jnp.maximum(m_inter, jnp.max(dmat, axis=-1))
        w_inter = jnp.exp(m_inter - m_t)
        s = jnp.einsum('bhtd,bhsd->bhts', qc, kc) * jnp.exp(dmat - m_t[..., None])
        num = jnp.einsum('bhts,bhse->bhte', s, vc) + w_inter[..., None] * jnp.einsum('bhtd,bhed->bhte', qc, cmat)
        den = jnp.sum(s, axis=-1) + w_inter * jnp.einsum('bhtd,bhd->bht', qc, nvec)
        h = num / jnp.maximum(jnp.abs(den), jnp.exp(-m_t))[..., None]
        bl = bcum[..., -1]
        g = bl[..., None] - bcum + ic
        m_new = jnp.maximum(bl + m, jnp.max(g, axis=-1))
        decay = jnp.exp(bl + m - m_new)
        wk = jnp.exp(g - m_new[..., None])
        cmat = decay[..., None, None] * cmat + jnp.einsum('bhs,bhse,bhsd->bhed', wk, vc, kc)
        nvec = decay[..., None] * nvec + jnp.einsum('bhs,bhsd->bhd', wk, kc)
        return (cmat, nvec, m_new), h

    state, hs = lax.scan(step, state, xs)
    return from_chunks(hs), state


def gla_scan(q, k, v, la, state):
    xs = tuple(to_chunks(a.astype(jnp.float32)) for a in (q, k, v, la))
    tril = jnp.tril(jnp.ones((CHUNK, CHUNK), dtype=bool))

    def step(smat, inp):
        qc, kc, vc, ac = inp
        bcum = jnp.cumsum(ac, axis=2)
        qe = qc * jnp.exp(bcum)
        ke = kc * jnp.exp(-bcum)
        a = jnp.where(tril, jnp.einsum('bhtd,bhsd->bhts', qe, ke), 0.0)
        o = jnp.einsum('bhts,bhse->bhte', a, vc) + jnp.einsum('bhtd,bhde->bhte', qe, smat)
        bl = bcum[:, :, -1]
        kd = kc * jnp.exp(bl[:, :, None] - bcum)
        smat = jnp.exp(bl)[..., None] * smat + jnp.einsum('bhsd,bhse->bhde', kd, vc)
        return smat, o

    state, os_ = lax.scan(step, state, xs)
    return from_chunks(os_), state


def bidir_scan(scan, qkv_c, qkv_x, gc_f, gc_b, gx_f, gx_b, st0, need_ctx):
    def rev(arrs):
        return tuple(jnp.flip(a, axis=1) for a in arrs)
    yc_f, s_f = scan(*qkv_c, *gc_f, st0)
    yc_b, s_b = scan(*rev(qkv_c), *rev(gc_b), st0)
    yx_f, _ = scan(*qkv_x, *gx_f, s_f)
    yx_b, _ = scan(*rev(qkv_x), *rev(gx_b), s_b)
    yx = yx_f + jnp.flip(yx_b, axis=1)
    yc = yc_f + jnp.flip(yc_b, axis=1) if need_ctx else None
    return yx, yc


def even_mixer(hx, hc, w_in, w_out, diff_lambda, diff_norm_g, conv_w, conv_b, gate_b, ml_norm_g,
               lam_init, rope, need_ctx):
    dt = hx.dtype
    px = _split(hx @ w_in, EVEN_SPLITS)
    pc = _split(hc @ w_in, EVEN_SPLITS)
    lp = diff_lambda.astype(jnp.float32)
    lam = jnp.exp(jnp.sum(lp[0] * lp[1])) - jnp.exp(jnp.sum(lp[2] * lp[3])) + lam_init

    def da_heads(p):
        b, t = p[0].shape[:2]
        return (p[0].reshape(b, t, DA_HEADS, 2, DA_HD), p[1].reshape(b, t, DA_HEADS, 2, DA_HD),
                p[2].reshape(b, t, DA_HEADS, DA_VD))

    def ml_heads(p):
        b, t = p[0].shape[:2]
        qk = jax.nn.silu(dw_conv(p[3], conv_w, conv_b))
        q, k = jnp.split(qk, 2, axis=-1)
        q = q.reshape(b, t, ML_HEADS, ML_QK) * (ML_QK ** -0.5)
        k = k.reshape(b, t, ML_HEADS, ML_QK)
        v = p[4].reshape(b, t, ML_HEADS, ML_V)
        g = (p[6] + gate_b.reshape(-1)).astype(jnp.float32).reshape(b, t, 4, ML_HEADS)
        fwd = (g[:, :, 0], jax.nn.log_sigmoid(g[:, :, 2]))
        bwd = (g[:, :, 1], jax.nn.log_sigmoid(g[:, :, 3]))
        return (q, k, v), fwd, bwd

    def merge(attn, mem, o_pre):
        b, t = attn.shape[:2]
        a = (rms_norm(attn, diff_norm_g) * (1.0 - lam_init)).reshape(b, t, -1)
        m = rms_norm(mem, ml_norm_g).reshape(b, t, -1) * jax.nn.sigmoid(o_pre)
        return jnp.concatenate([a, m], axis=-1).astype(dt) @ w_out

    qx, kx, vx = da_heads(px)
    qc, kc, vc = da_heads(pc)
    qx = rope_2d(qx, rope)
    kx = rope_2d(kx, rope)
    ax = diff_attn_latent(qx, jnp.concatenate([kc, kx], axis=1), jnp.concatenate([vc, vx], axis=1), lam)

    qkv_x, gx_f, gx_b = ml_heads(px)
    qkv_c, gc_f, gc_b = ml_heads(pc)
    bsz = hx.shape[0]
    st0 = (jnp.zeros((bsz, ML_HEADS, ML_V, ML_QK), jnp.float32),
           jnp.zeros((bsz, ML_HEADS, ML_QK), jnp.float32),
           jnp.zeros((bsz, ML_HEADS), jnp.float32))
    mx, mc = bidir_scan(mlstm_scan, qkv_c, qkv_x, gc_f, gc_b, gx_f, gx_b, st0, need_ctx)

    out_x = merge(ax, mx, px[5])
    out_c = merge(diff_softmax_core(qc, kc, vc, lam), mc, pc[5]) if need_ctx else None
    return out_x, out_c


def odd_mixer(hx, hc, w_in, w_out, w_gate, b_gate, norm_g, need_ctx):
    dt = hx.dtype
    px = _split(hx @ w_in, ODD_SPLITS)
    pc = _split(hc @ w_in, ODD_SPLITS)

    def heads(p):
        b, t = p[0].shape[:2]
        q = p[0].reshape(b, t, GLA_HEADS, GLA_K) * (GLA_K ** -0.5)
        k = p[1].reshape(b, t, GLA_HEADS, GLA_K)
        v = p[2].reshape(b, t, GLA_HEADS, GLA_V)
        lr_f, lr_b = jnp.split(p[4], 2, axis=-1)

        def decay(lr, d):
            z = (lr @ w_gate[d] + b_gate[d]).astype(jnp.float32)
            return (jax.nn.log_sigmoid(z) / GLA_TAU).reshape(b, t, GLA_HEADS, GLA_K)
        return (q, k, v), (decay(lr_f, 0),), (decay(lr_b, 1),)

    def merge(o, r):
        b, t = o.shape[:2]
        y = rms_norm(o, norm_g).reshape(b, t, -1) * jax.nn.silu(r)
        return y.astype(dt) @ w_out

    qkv_x, gx_f, gx_b = heads(px)
    qkv_c, gc_f, gc_b = heads(pc)
    st0 = jnp.zeros((hx.shape[0], GLA_HEADS, GLA_K, GLA_V), jnp.float32)
    ox, oc = bidir_scan(gla_scan, qkv_c, qkv_x, gc_f, gc_b, gx_f, gx_b, st0, need_ctx)
    out_x = merge(ox, px[3])
    out_c = merge(oc, pc[3]) if need_ctx else None
    return out_x, out_c


def setup_inputs(seed: int = 0) -> dict:
    key = jax.random.key(seed)
    ks = iter(jax.random.split(key, 32))

    def nrm(shape, scale):
        return jax.random.normal(next(ks), shape, jnp.float32) * scale

    d = D_MODEL
    inv = d ** -0.5
    x = nrm((BATCH, SEQ, d), 1.0)
    c = nrm((BATCH, d), 1.0)
    ctx = nrm((BATCH, CTX_LEN, d), 1.0)
    c_ctx = nrm((d,), 1.0)
    ada_w = nrm((DEPTH, d, N_MOD * d), 0.3 * inv)
    ada_b = nrm((DEPTH, N_MOD * d), 0.02)
    norm_g = 1.0 + nrm((DEPTH, 3, d), 0.02)
    ffn_w_in = nrm((DEPTH, 2, d, 2 * D_FF), inv)
    ffn_w_out = nrm((DEPTH, 2, D_FF, d), D_FF ** -0.5)
    even_w_in = nrm((N_EVEN, d, EVEN_IN), inv)
    even_w_out = nrm((N_EVEN, d, d), inv)
    diff_lambda = nrm((N_EVEN, 4, DA_HD), 0.1)
    diff_norm_g = 1.0 + nrm((N_EVEN, DA_VD), 0.02)
    mlstm_conv_w = nrm((N_EVEN, ML_CONV, 2 * ML_HEADS * ML_QK), ML_CONV ** -0.5)
    mlstm_conv_b = nrm((N_EVEN, 2 * ML_HEADS * ML_QK), 0.02)
    fbias = jnp.concatenate([jnp.zeros((2, ML_HEADS), jnp.float32),
                             jnp.tile(jnp.linspace(3.0, 6.0, ML_HEADS, dtype=jnp.float32)[None], (2, 1))], axis=0)
    mlstm_gate_b = fbias[None] + nrm((N_EVEN, 4, ML_HEADS), 0.1)
    mlstm_norm_g = 1.0 + nrm((N_EVEN, ML_HEADS, ML_V), 0.02)
    odd_w_in = nrm((N_ODD, d, ODD_IN), inv)
    odd_w_out = nrm((N_ODD, d, d), inv)
    gla_w_gate = nrm((N_ODD, 2, GLA_RANK, GLA_HEADS * GLA_K), GLA_RANK ** -0.5)
    gla_b_gate = nrm((N_ODD, 2, GLA_HEADS * GLA_K), 0.1)
    gla_norm_g = 1.0 + nrm((N_ODD, GLA_V), 0.02)
    final_g = 1.0 + nrm((d,), 0.02)
    return {"x": x, "c": c, "ctx": ctx, "c_ctx": c_ctx, "ada_w": ada_w, "ada_b": ada_b,
            "norm_g": norm_g, "ffn_w_in": ffn_w_in, "ffn_w_out": ffn_w_out,
            "even_w_in": even_w_in, "even_w_out": even_w_out, "diff_lambda": diff_lambda,
            "diff_norm_g": diff_norm_g, "mlstm_conv_w": mlstm_conv_w, "mlstm_conv_b": mlstm_conv_b,
            "mlstm_gate_b": mlstm_gate_b, "mlstm_norm_g": mlstm_norm_g, "odd_w_in": odd_w_in,
            "odd_w_out": odd_w_out, "gla_w_gate": gla_w_gate, "gla_b_gate": gla_b_gate,
            "gla_norm_g": gla_norm_g, "final_g": final_g}


def reference(x, c, ctx, c_ctx, ada_w, ada_b, norm_g, ffn_w_in, ffn_w_out, even_w_in, even_w_out,
              diff_lambda, diff_norm_g, mlstm_conv_w, mlstm_conv_b, mlstm_gate_b, mlstm_norm_g,
              odd_w_in, odd_w_out, gla_w_gate, gla_b_gate, gla_norm_g, final_g):
    bsz, n_tok, d = x.shape
    rows = n_tok // GRID_W
    rope = axial_rope_tables(rows, x.dtype)
    s_lat = jax.nn.silu(c)
    s_ctx = jax.nn.silu(c_ctx)
    hctx = ctx
    for l in range(DEPTH):
        last = l == DEPTH - 1
        mx = (s_lat @ ada_w[l] + ada_b[l]).reshape(bsz, N_MOD, 1, d)
        mc = (s_ctx @ ada_w[l] + ada_b[l]).reshape(N_MOD, d)
        x = x + 0.5 * mx[:, 2] * swiglu(ada_norm(x, norm_g[l, 0], mx[:, 0], mx[:, 1]), ffn_w_in[l, 0], ffn_w_out[l, 0])
        hctx = hctx + 0.5 * mc[2] * swiglu(ada_norm(hctx, norm_g[l, 0], mc[0], mc[1]), ffn_w_in[l, 0], ffn_w_out[l, 0])
        hx = ada_norm(x, norm_g[l, 1], mx[:, 3], mx[:, 4])
        hc = ada_norm(hctx, norm_g[l, 1], mc[3], mc[4])
        if l % 2 == 0:
            e = l // 2
            lam_init = 0.8 - 0.6 * math.exp(-0.3 * l)
            yx, yc = even_mixer(hx, hc, even_w_in[e], even_w_out[e], diff_lambda[e], diff_norm_g[e],
                                mlstm_conv_w[e], mlstm_conv_b[e], mlstm_gate_b[e], mlstm_norm_g[e],
                                lam_init, rope, not last)
        else:
            o = l // 2
            yx, yc = odd_mixer(hx, hc, odd_w_in[o], odd_w_out[o], gla_w_gate[o], gla_b_gate[o],
                               gla_norm_g[o], not last)
        x = x + mx[:, 5] * yx
        x = x + 0.5 * mx[:, 8] * swiglu(ada_norm(x, norm_g[l, 2], mx[:, 6], mx[:, 7]), ffn_w_in[l, 1], ffn_w_out[l, 1])
        if not last:
            hctx = hctx + mc[5] * yc
            hctx = hctx + 0.5 * mc[8] * swiglu(ada_norm(hctx, norm_g[l, 2], mc[6], mc[7]), ffn_w_in[l, 1], ffn_w_out[l, 1])
    return rms_norm(x, final_g)
```

```cpp
#include <hip/hip_runtime.h>
#include <hip/hip_cooperative_groups.h>
#include <cstdio>
#include <type_traits>
namespace cg = cooperative_groups;

#ifndef ONE_LAUNCH
#define ONE_LAUNCH 1
#endif

#define DI __device__ __forceinline__
#define LAS __attribute__((address_space(3)))
typedef unsigned short bf16_t;
typedef short bf16x8 __attribute__((ext_vector_type(8)));
typedef short s16x4 __attribute__((ext_vector_type(4)));
typedef float f32x4 __attribute__((ext_vector_type(4)));
typedef unsigned u32x4 __attribute__((ext_vector_type(4)));
typedef unsigned u32x2 __attribute__((ext_vector_type(2)));

constexpr int D = 1024, NB = 8, SEQ = 4096, CTXL = 256;
constexpr int TCTX = NB * CTXL;
constexpr int TLAT = NB * SEQ;
constexpr int T = TCTX + TLAT;
constexpr int DFF = 2816, NFF = 5632;
constexpr int PN = 3328;
constexpr int PLD = 3104;
constexpr int NMOD = 9 * D;
constexpr float EPS = 1e-6f;
constexpr int NTHREADS = 512;
constexpr int LDS_BYTES = 147456;

constexpr size_t WS_CTL = 0;
constexpr size_t WS_MODS = 16384;
constexpr size_t WS_GATES = WS_MODS + (size_t)2 * 9 * NMOD * 4;
constexpr size_t WS_XC = WS_GATES + (size_t)T * 16 * 4;
constexpr size_t WS_WFI = WS_XC + (size_t)TCTX * D * 4;
constexpr size_t SZ_WFI = (size_t)NFF * D * 2;
constexpr size_t WS_WFO = WS_WFI + 4 * SZ_WFI;
constexpr size_t SZ_WFO = (size_t)D * DFF * 2;
constexpr size_t WS_WMI = WS_WFO + 4 * SZ_WFO;
constexpr size_t SZ_WMI = (size_t)PN * D * 2;
constexpr size_t WS_WMO = WS_WMI + 2 * SZ_WMI;
constexpr size_t SZ_WMO = (size_t)D * D * 2;
constexpr size_t WS_HB = WS_WMO + 2 * SZ_WMO;
constexpr size_t WS_PH = WS_HB + (size_t)T * D * 2;
constexpr size_t WS_SC = WS_PH + (size_t)T * PLD * 2;
constexpr size_t WS_ROPE = WS_SC + (size_t)T * D * 2 * 2;
constexpr size_t WS_END = WS_ROPE + 8192;

struct Params {
    const float *x, *c, *ctx, *c_ctx, *ada_w, *ada_b, *norm_g, *ffn_w_in, *ffn_w_out, *even_w_in, *even_w_out, *diff_lambda, *diff_norm_g,
        *conv_w, *conv_b, *gate_b, *ml_norm_g, *odd_w_in, *odd_w_out, *gla_w_gate, *gla_b_gate, *gla_norm_g, *final_g;
    float* out;
    unsigned char* ws;
    int ph_lo, ph_hi, coop, pad;
};

DI int tid_op() { int t = threadIdx.x; asm volatile("" : "+v"(t)); return t; }
DI int bid_op() { int b = blockIdx.x; asm volatile("" : "+s"(b)); return b; }
DI bf16_t f2bf(float f) { unsigned u = __float_as_uint(f); u += 0x7fffu + ((u >> 16) & 1u); return (bf16_t)(u >> 16); }
DI float bf2f(bf16_t b) { return __uint_as_float(((unsigned)b) << 16); }
typedef __bf16 hbf2 __attribute__((ext_vector_type(2)));
typedef float f32x2 __attribute__((ext_vector_type(2)));
DI unsigned pack2(float lo, float hi) { const f32x2 v = {lo, hi}; const hbf2 r = __builtin_convertvector(v, hbf2); return __builtin_bit_cast(unsigned, r); }
DI float siluf(float a) { return a * __builtin_amdgcn_rcpf(1.f + __expf(-a)); }
DI float sigmoidf(float a) { return __builtin_amdgcn_rcpf(1.f + __expf(-a)); }
DI float logsigf(float x) { return fminf(x, 0.f) - __logf(1.f + __expf(-fabsf(x))); }
DI void lds_barrier() { asm volatile("s_waitcnt lgkmcnt(0)" ::: "memory"); __builtin_amdgcn_s_barrier(); asm volatile("" ::: "memory"); }
DI f32x4 mfma16(bf16x8 a, bf16x8 b, f32x4 c) { return __builtin_amdgcn_mfma_f32_16x16x32_bf16(a, b, c, 0, 0, 0); }
DI bf16x8 ldfrag(const bf16_t* base, int ld, int row, int k0) { return *(const bf16x8*)(base + row * ld + k0); }
DI float wave_sum(float v) { for (int o = 32; o > 0; o >>= 1) v += __shfl_xor(v, o); return v; }
DI float wave_max(float v) { for (int o = 32; o > 0; o >>= 1) v = fmaxf(v, __shfl_xor(v, o)); return v; }
DI const float* xrow_src(const float* sc, const float* sl, int row) { return row < TCTX ? sc + (size_t)row * D : sl + (size_t)(row - TCTX) * D; }
DI float* xrow_dst(float* sc, float* sl, int row) { return row < TCTX ? sc + (size_t)row * D : sl + (size_t)(row - TCTX) * D; }
DI int mod_row(int row) { return row < TCTX ? 8 : (row - TCTX) >> 12; }

namespace g8 {
constexpr int BM = 256, BK = 64, HALF = 128, HTB = HALF * BK * 2, NXCD = 8, WGM = 8;
DI int lds_byte(int r, int c) { const int st = (r >> 4) * 2 + (c >> 5), rr = r & 15, cc = c & 31, ob = rr * 64 + cc * 2; return st * 1024 + (ob ^ (((ob >> 9) & 1) << 5)); }
DI void stage_rc(int b, int& R, int& C) { const int st = b / 1024, sb = b % 1024, swz = sb ^ (((sb >> 9) & 1) << 5); R = (st >> 1) * 16 + swz / 64; C = (st & 1) * 32 + (swz % 64) / 2; }
DI int perm32(int rho) { const int n = rho >> 4, i = rho & 15; return 8 * (i >> 2) + 4 * n + (i & 3); }
struct Unit { int pm, pn; };
struct Gemm { const bf16_t* A; const bf16_t* Bt; int M, N, K, ld; };
struct SingleUnit { Unit u; DI bool next(int i, Unit& o) const { if (i != 0) return false; o = u; return true; } };
struct StaticOrder {
    int nM, nN, nwg, G, c;
    DI void init(int M, int N, int G_, int c_) { nM = M / BM; nN = N / BM; nwg = nM * nN; G = G_; c = c_; }
    DI bool next(int i, Unit& u) const {
        const long L = (long)i * G + c; if (L >= nwg) return false;
        int wgid = (int)L; { const int q = nwg / NXCD, r = nwg % NXCD, xcd = wgid % NXCD, off = wgid / NXCD; wgid = (xcd < r ? xcd * (q + 1) : r * (q + 1) + (xcd - r) * q) + off; }
        const int nig = WGM * nN, gid = wgid / nig, fm = gid * WGM, gsz = (nM - fm) < WGM ? (nM - fm) : WGM;
        u.pm = fm + ((wgid % nig) % gsz); u.pn = (wgid % nig) / gsz; return true;
    }
};

template <class Epi, class Sched>
DI void gemm_phase(LAS unsigned char* lds, const Gemm g, const Sched& S, const Epi& E) {
    const int tid = tid_op(), wid = __builtin_amdgcn_readfirstlane(tid >> 6), lane = tid & 63, wr = wid >> 2, wc = wid & 3, fr = lane & 15, fq = lane >> 4;
    const int K = g.K, nt = K / BK, LD = g.ld;
    unsigned voffA[2], voffB[2];
#pragma unroll
    for (int i = 0; i < 2; ++i) { int R, C; stage_rc(tid * 16 + i * 8192, R, C); const int Rb = Epi::PERM ? ((R & ~31) + perm32(R & 31)) : R;
        voffA[i] = (unsigned)(R * LD + C) * 2u; voffB[i] = (unsigned)(Rb * LD + C) * 2u; }
    const size_t kstep = (size_t)(BK * 2);
    const size_t hstep = (size_t)HALF * LD * 2;
    const size_t tstep = 2 * hstep;
    const unsigned ldsw = (unsigned)wid * 1024u;
    const int aoff = lds_byte(wr * 64 + fr, fq * 8), boff = lds_byte(wc * 32 + fr, fq * 8);
#define G8_SA(b, h) (((b) * 2 + (h)) * HTB)
#define G8_SB(b, h) ((4 + (b) * 2 + (h)) * HTB)
#define G8_STAGE(bufoff, gbase, voff) do { _Pragma("unroll") for (int _i = 0; _i < 2; ++_i) \
        __builtin_amdgcn_global_load_lds((const unsigned*)((const char*)(gbase) + (voff)[_i]), (LAS unsigned*)(lds + (bufoff) + ldsw + _i * 8192), 16, 0, 0); } while (0)
#define G8_LDA(dst, b, h) do { _Pragma("unroll") for (int m = 0; m < 4; ++m) _Pragma("unroll") for (int k = 0; k < 2; ++k) dst[m][k] = *(const LAS bf16x8*)(lds + G8_SA(b, h) + aoff + m * 2048 + k * 1024); } while (0)
#define G8_LDB(dst, b, h) do { _Pragma("unroll") for (int n = 0; n < 2; ++n) _Pragma("unroll") for (int k = 0; k < 2; ++k) dst[n][k] = *(const LAS bf16x8*)(lds + G8_SB(b, h) + boff + n * 2048 + k * 1024); } while (0)
#define G8_MMA(ai, bj, At, Bt) do { __builtin_amdgcn_s_setprio(1); _Pragma("unroll") for (int m = 0; m < 4; ++m) _Pragma("unroll") for (int n = 0; n < 2; ++n) _Pragma("unroll") for (int k = 0; k < 2; ++k) \
        acc[ai][bj][m][n] = __builtin_amdgcn_mfma_f32_16x16x32_bf16(Bt[n][k], At[m][k], acc[ai][bj][m][n], 0, 0, 0); __builtin_amdgcn_s_setprio(0); } while (0)
#define G8_WAIT_V(n) asm volatile("s_waitcnt vmcnt(" #n ")" ::: "memory")
#define G8_WAIT_L(n) asm volatile("s_waitcnt lgkmcnt(" #n ")" ::: "memory")
#define G8_BAR __builtin_amdgcn_s_barrier()
#define G8_SCHED __builtin_amdgcn_sched_barrier(0)
    Unit cur, nxt; int ui = 0;
    if (!S.next(0, cur)) return;
    f32x4 acc[2][2][4][2];
#pragma unroll
    for (int a = 0; a < 2; ++a)
#pragma unroll
        for (int b = 0; b < 2; ++b)
#pragma unroll
            for (int m = 0; m < 4; ++m)
#pragma unroll
                for (int n = 0; n < 2; ++n) acc[a][b][m][n] = (f32x4){0.f, 0.f, 0.f, 0.f};
    bf16x8 At[4][2], B0[2][2], B1[2][2];
    const char* cA = (const char*)g.A + (size_t)cur.pm * tstep; const char* cB = (const char*)g.Bt + (size_t)cur.pn * tstep;
    G8_STAGE(G8_SB(0, 0), cB, voffB); G8_STAGE(G8_SA(0, 0), cA, voffA); G8_STAGE(G8_SB(0, 1), cB + hstep, voffB); G8_STAGE(G8_SA(0, 1), cA + hstep, voffA);
    if (wr == 1) G8_BAR;
    G8_WAIT_V(4); G8_BAR;
    G8_STAGE(G8_SB(1, 0), cB + kstep, voffB); G8_STAGE(G8_SA(1, 0), cA + kstep, voffA); G8_STAGE(G8_SB(1, 1), cB + hstep + kstep, voffB);
    G8_WAIT_V(6); G8_BAR;
    for (;;) {
        const bool has_next = S.next(ui + 1, nxt);
        const char* nA = has_next ? (const char*)g.A + (size_t)nxt.pm * tstep : cA; const char* nB = has_next ? (const char*)g.Bt + (size_t)nxt.pn * tstep : cB;
        for (int t = 0; t < nt; t += 2) {
            const bool last = (t == nt - 2);
            const char* a1 = cA + (size_t)(t + 1) * kstep;
            const char* a2 = last ? nA : cA + (size_t)(t + 2) * kstep; const char* b2 = last ? nB : cB + (size_t)(t + 2) * kstep;
            const char* a3 = a2 + kstep; const char* b3 = b2 + kstep;
            G8_LDB(B0, 0, 0); G8_SCHED; G8_LDA(At, 0, 0); G8_STAGE(G8_SA(1, 1), a1 + hstep, voffA);
            G8_WAIT_L(8); G8_BAR; G8_WAIT_L(0); G8_MMA(0, 0, At, B0); G8_BAR; G8_SCHED;
            G8_LDB(B1, 0, 1); G8_STAGE(G8_SB(0, 0), b2, voffB);
            G8_BAR; G8_WAIT_L(0); G8_MMA(0, 1, At, B1); G8_BAR;
            G8_LDA(At, 0, 1); G8_STAGE(G8_SA(0, 0), a2, voffA);
            G8_BAR; G8_WAIT_L(0); G8_MMA(1, 0, At, B0); G8_BAR; G8_SCHED;
            G8_STAGE(G8_SB(0, 1), b2 + hstep, voffB);
            G8_WAIT_V(6); G8_BAR; G8_MMA(1, 1, At, B1); G8_BAR;
            G8_LDB(B0, 1, 0); G8_SCHED; G8_LDA(At, 1, 0); G8_STAGE(G8_SA(0, 1), a2 + hstep, voffA);
            G8_WAIT_L(8); G8_BAR; G8_WAIT_L(0); G8_MMA(0, 0, At, B0); G8_BAR; G8_SCHED;
            G8_LDB(B1, 1, 1); G8_STAGE(G8_SB(1, 0), b3, voffB);
            G8_BAR; G8_WAIT_L(0); G8_MMA(0, 1, At, B1); G8_BAR;
            G8_LDA(At, 1, 1); G8_STAGE(G8_SA(1, 0), a3, voffA);
            G8_BAR; G8_WAIT_L(0); G8_MMA(1, 0, At, B0); G8_BAR; G8_SCHED;
            G8_STAGE(G8_SB(1, 1), b3 + hstep, voffB);
            G8_WAIT_V(6); G8_BAR; G8_MMA(1, 1, At, B1); G8_BAR;
        }
        E(acc, cur, wr, wc, fr, fq);
        if (!has_next) break;
#pragma unroll
        for (int a = 0; a < 2; ++a)
#pragma unroll
            for (int b = 0; b < 2; ++b)
#pragma unroll
                for (int m = 0; m < 4; ++m)
#pragma unroll
                    for (int n = 0; n < 2; ++n) acc[a][b][m][n] = (f32x4){0.f, 0.f, 0.f, 0.f};
        cur = nxt; cA = nA; cB = nB; ++ui;
    }
    G8_WAIT_V(0);
    if (wr == 0) G8_BAR;
    G8_BAR;
#undef G8_SA
#undef G8_SB
#undef G8_STAGE
#undef G8_LDA
#undef G8_LDB
#undef G8_MMA
#undef G8_WAIT_V
#undef G8_WAIT_L
#undef G8_BAR
#undef G8_SCHED
}

struct EpiSwiglu {
    static constexpr bool PERM = true;
    bf16_t* H; int row_base;
    DI void operator()(const f32x4 (&acc)[2][2][4][2], const Unit& u, int wr, int wc, int fr, int fq) const {
        const int row0 = row_base + u.pm * BM + wr * 64 + fr, col0 = u.pn * 128 + wc * 32 + 8 * fq;
#pragma unroll
        for (int ai = 0; ai < 2; ++ai)
#pragma unroll
            for (int m = 0; m < 4; ++m) {
                bf16_t* rowp = H + (size_t)(row0 + ai * HALF + m * 16) * DFF + col0;
                const f32x4 a0 = acc[ai][0][m][0], a1 = acc[ai][0][m][1], b0 = acc[ai][1][m][0], b1 = acc[ai][1][m][1];
                u32x4 o;
                o[0] = pack2(siluf(a0[0]) * b0[0], siluf(a0[1]) * b0[1]); o[1] = pack2(siluf(a0[2]) * b0[2], siluf(a0[3]) * b0[3]);
                o[2] = pack2(siluf(a1[0]) * b1[0], siluf(a1[1]) * b1[1]); o[3] = pack2(siluf(a1[2]) * b1[2], siluf(a1[3]) * b1[3]);
                *(u32x4*)rowp = o;
            }
    }
};
struct EpiResid {
    static constexpr bool PERM = false;
    const float* src_ctx; const float* src_lat; float* dst_ctx; float* dst_lat; const float* mods; int gate_idx; float coef; int row_base;
    DI void operator()(const f32x4 (&acc)[2][2][4][2], const Unit& u, int wr, int wc, int fr, int fq) const {
        const int trow = row_base + u.pm * BM;
        const float* gate = mods + (size_t)mod_row(trow) * NMOD + gate_idx * D;
        const float* Sp = xrow_src(src_ctx, src_lat, trow); float* Dp = xrow_dst(dst_ctx, dst_lat, trow);
        const int r0 = wr * 64 + fr, col0 = u.pn * BM + wc * 32 + 4 * fq;
        auto& A = const_cast<f32x4 (&)[2][2][4][2]>(acc);
        {
            f32x4 gv[2][2];
            __builtin_amdgcn_sched_barrier(0);
#pragma unroll
            for (int bj = 0; bj < 2; ++bj)
#pragma unroll
                for (int n = 0; n < 2; ++n) gv[bj][n] = *(const f32x4*)(gate + col0 + bj * HALF + n * 16);
            __builtin_amdgcn_sched_barrier(0);
#pragma unroll
            for (int bj = 0; bj < 2; ++bj)
#pragma unroll
                for (int n = 0; n < 2; ++n) {
                    const f32x4 gvv = gv[bj][n] * coef;
#pragma unroll
                    for (int ai = 0; ai < 2; ++ai)
#pragma unroll
                        for (int m = 0; m < 4; ++m) { A[ai][bj][m][n] *= gvv; asm volatile("" : "+v"(A[ai][bj][m][n])); }
                }
        }
        auto batch = [&](auto MM, int ai, int m0) {
            constexpr int NM = decltype(MM)::value;
            f32x4 xv[NM][2][2];
            __builtin_amdgcn_sched_barrier(0);
#pragma unroll
            for (int mm = 0; mm < NM; ++mm)
#pragma unroll
                for (int bj = 0; bj < 2; ++bj)
#pragma unroll
                    for (int n = 0; n < 2; ++n) xv[mm][bj][n] = *(const f32x4*)(Sp + (size_t)(r0 + ai * HALF + (m0 + mm) * 16) * D + col0 + bj * HALF + n * 16);
            __builtin_amdgcn_sched_barrier(0);
            asm volatile("s_waitcnt vmcnt(0)" ::: "memory");
            __builtin_amdgcn_sched_barrier(0);
#pragma unroll
            for (int mm = 0; mm < NM; ++mm)
#pragma unroll
                for (int bj = 0; bj < 2; ++bj)
#pragma unroll
                    for (int n = 0; n < 2; ++n) *(f32x4*)(Dp + (size_t)(r0 + ai * HALF + (m0 + mm) * 16) * D + col0 + bj * HALF + n * 16) = xv[mm][bj][n] + A[ai][bj][m0 + mm][n];
            asm volatile("" ::: "memory");
        };
        __builtin_amdgcn_sched_barrier(0);
        batch(std::integral_constant<int, 2>{}, 0, 0); batch(std::integral_constant<int, 2>{}, 0, 2);
        batch(std::integral_constant<int, 2>{}, 1, 0); batch(std::integral_constant<int, 2>{}, 1, 2);
    }
};
struct EpiPartial {
    static constexpr bool PERM = false;
    bf16_t* slab; const float* gate; float coef;
    DI void operator()(const f32x4 (&acc)[2][2][4][2], const Unit& u, int wr, int wc, int fr, int fq) const {
        const int r0 = u.pm * BM + wr * 64 + fr, col0 = u.pn * BM + wc * 32 + 4 * fq;
#pragma unroll
        for (int bj = 0; bj < 2; ++bj)
#pragma unroll
            for (int n = 0; n < 2; ++n) {
                const f32x4 gv = *(const f32x4*)(gate + col0 + bj * HALF + n * 16) * coef;
#pragma unroll
                for (int ai = 0; ai < 2; ++ai)
#pragma unroll
                    for (int m = 0; m < 4; ++m) {
                        const f32x4 v = gv * acc[ai][bj][m][n];
                        u32x2 o; o[0] = pack2(v[0], v[1]); o[1] = pack2(v[2], v[3]);
                        *(u32x2*)(slab + (size_t)(r0 + ai * HALF + m * 16) * D + col0 + bj * HALF + n * 16) = o;
                    }
            }
    }
};
struct EpiP {
    static constexpr bool PERM = true;
    bf16_t* P; float* gates; const float* gate_b;
    DI void operator()(const f32x4 (&acc)[2][2][4][2], const Unit& u, int wr, int wc, int fr, int fq) const {
        const int row0 = u.pm * BM + wr * 64 + fr;
#pragma unroll
        for (int bj = 0; bj < 2; ++bj) {
            const int col0 = u.pn * BM + bj * HALF + wc * 32 + 8 * fq;
            if (col0 >= PLD) continue;
            const bool isg = gates != nullptr && col0 >= 3072 && col0 < 3088;
#pragma unroll
            for (int ai = 0; ai < 2; ++ai)
#pragma unroll
                for (int m = 0; m < 4; ++m) {
                    const int row = row0 + ai * HALF + m * 16;
                    const f32x4 v0 = acc[ai][bj][m][0], v1 = acc[ai][bj][m][1];
                    u32x4 o; o[0] = pack2(v0[0], v0[1]); o[1] = pack2(v0[2], v0[3]); o[2] = pack2(v1[0], v1[1]); o[3] = pack2(v1[2], v1[3]);
                    *(u32x4*)(P + (size_t)row * PLD + col0) = o;
                    if (isg) {
                        const int gc = col0 - 3072;
                        float* gp = gates + (size_t)row * 16 + gc;
                        const f32x4 b0 = *(const f32x4*)(gate_b + gc), b1 = *(const f32x4*)(gate_b + gc + 4);
                        *(f32x4*)gp = v0 + b0; *(f32x4*)(gp + 4) = v1 + b1;
                    }
                }
        }
    }
};
}

struct TrJob { const float* src; bf16_t* dst; int K, Nsrc, Nvalid, mode, tk, tn; };
DI void tr_load(const TrJob& j, f32x4 (&r)[8]) {
    const int tid = tid_op(), n = j.tn * 256 + (tid & 63) * 4, k0 = j.tk * 64;
    const int sc = j.mode == 1 ? ((n >> 7) & 1) * DFF + (n >> 8) * 128 + (n & 127) : n;
#pragma unroll
    for (int it = 0; it < 8; ++it) { const int kk = it * 8 + (tid >> 6); r[it] = (n < j.Nvalid) ? *(const f32x4*)(j.src + (size_t)(k0 + kk) * j.Nsrc + sc) : (f32x4){0.f, 0.f, 0.f, 0.f}; }
}
DI void tr_store(const TrJob& j, const f32x4 (&r)[8], float* tile) {
    const int tid = tid_op(), n0 = j.tn * 256, k0 = j.tk * 64;
#pragma unroll
    for (int it = 0; it < 8; ++it) {
        float* tp = tile + (it * 8 + (tid >> 6)) * 257 + (tid & 63) * 4;
        tp[0] = r[it][0]; tp[1] = r[it][1]; tp[2] = r[it][2]; tp[3] = r[it][3];
    }
    __syncthreads();
    {
        const int g = tid & 7;
#pragma unroll
        for (int it = 0; it < 4; ++it) {
            const int rr = it * 64 + (tid >> 3);
            const float* tp = tile + (8 * g) * 257 + rr;
            u32x4 o;
            o[0] = pack2(tp[0], tp[257]); o[1] = pack2(tp[2 * 257], tp[3 * 257]); o[2] = pack2(tp[4 * 257], tp[5 * 257]); o[3] = pack2(tp[6 * 257], tp[7 * 257]);
            *(u32x4*)(j.dst + (size_t)(n0 + rr) * j.K + k0 + 8 * g) = o;
        }
    }
    __syncthreads();
}

DI void phase_prep(const Params& p, unsigned char* smem) {
    const int tid = tid_op(), bid = bid_op(), nblk = gridDim.x;
    if (bid == 0) { float* rt = (float*)(p.ws + WS_ROPE);
        for (int i = tid; i < 1024; i += NTHREADS) { const int pos = i >> 4, f = i & 15; float sn, cs; sincosf((float)pos * powf(10000.0f, -(float)f * (2.0f / 32.0f)), &sn, &cs); rt[2 * i] = cs; rt[2 * i + 1] = sn; } }
    { const f32x4* src = (const f32x4*)p.ctx; f32x4* dst = (f32x4*)(p.ws + WS_XC);
      for (int i = bid * NTHREADS + tid; i < TCTX * D / 4; i += nblk * NTHREADS) dst[i] = src[i]; }
    float* tile = (float*)smem;
    constexpr int N_FI = 16 * 22, N_FO = 44 * 4, N_MI = 16 * 13, N_MO = 16 * 4;
    constexpr int E_FI = 4 * N_FI, E_FO = E_FI + 4 * N_FO, E_MI = E_FO + 2 * N_MI, E_MO = E_MI + 2 * N_MO;
    auto decode = [&](int it) -> TrJob {
        TrJob j;
        if (it < E_FI) { const int q = it / N_FI, t = it % N_FI; j = TrJob{p.ffn_w_in + (size_t)q * D * NFF, (bf16_t*)(p.ws + WS_WFI + q * SZ_WFI), D, NFF, NFF, 1, t % 16, t / 16}; }
        else if (it < E_FO) { const int i2 = it - E_FI, q = i2 / N_FO, t = i2 % N_FO; j = TrJob{p.ffn_w_out + (size_t)q * DFF * D, (bf16_t*)(p.ws + WS_WFO + q * SZ_WFO), DFF, D, D, 0, t % 44, t / 44}; }
        else if (it < E_MI) { const int i2 = it - E_FO, q = i2 / N_MI, t = i2 % N_MI; j = TrJob{q == 0 ? p.even_w_in : p.odd_w_in, (bf16_t*)(p.ws + WS_WMI + q * SZ_WMI), D, q == 0 ? 3088 : 3104, q == 0 ? 3088 : 3104, 0, t % 16, t / 16}; }
        else { const int i2 = it - E_MI, q = i2 / N_MO, t = i2 % N_MO; j = TrJob{q == 0 ? p.even_w_out : p.odd_w_out, (bf16_t*)(p.ws + WS_WMO + q * SZ_WMO), D, D, D, 0, t % 16, t / 16}; }
        return j;
    };
    {
        f32x4 r0[8], r1[8], r2[8];
        int it = bid;
        if (it < E_MO) { TrJob j = decode(it); tr_load(j, r0); }
        if (it + nblk < E_MO) { TrJob j = decode(it + nblk); tr_load(j, r1); }
        for (;;) {
            if (it >= E_MO) break;
            if (it + 2 * nblk < E_MO) { TrJob jn = decode(it + 2 * nblk); tr_load(jn, r2); }
            { TrJob j = decode(it); tr_store(j, r0, tile); } it += nblk;
            if (it >= E_MO) break;
            if (it + 2 * nblk < E_MO) { TrJob jn = decode(it + 2 * nblk); tr_load(jn, r0); }
            { TrJob j = decode(it); tr_store(j, r1, tile); } it += nblk;
            if (it >= E_MO) break;
            if (it + 2 * nblk < E_MO) { TrJob jn = decode(it + 2 * nblk); tr_load(jn, r1); }
            { TrJob j = decode(it); tr_store(j, r2, tile); } it += nblk;
        }
    }
    float* sv = (float*)smem;
    f32x4* red = (f32x4*)(smem + 9 * D * 4);
    bool staged = false;
    for (int ch = bid; ch < 256; ch += nblk) {
        if (!staged) {
            __syncthreads();
            for (int i = tid; i < 9 * D; i += NTHREADS) { const float v = i < 8 * D ? p.c[i] : p.c_ctx[i - 8 * D]; sv[i] = siluf(v); }
            __syncthreads(); staged = true;
        }
        const int l = ch >> 7, j0 = (ch & 127) * 72, cg = tid % 18, kg = tid / 18;
        if (kg < 28) {
            f32x4 a[9];
#pragma unroll
            for (int r = 0; r < 9; ++r) a[r] = (f32x4){0.f, 0.f, 0.f, 0.f};
            const float* w = p.ada_w + (size_t)l * D * NMOD + j0 + 4 * cg;
            const int k1 = (kg + 1) * 37 < D ? (kg + 1) * 37 : D;
#pragma unroll 4
            for (int k = kg * 37; k < k1; ++k) {
                const f32x4 wv = *(const f32x4*)(w + (size_t)k * NMOD);
#pragma unroll
                for (int r = 0; r < 9; ++r) a[r] += wv * sv[r * D + k];
            }
#pragma unroll
            for (int r = 0; r < 9; ++r) red[(kg * 9 + r) * 18 + cg] = a[r];
        }
        __syncthreads();
        if (tid < 162) {
            const int r = tid / 18, cc = tid % 18; f32x4 sacc = (f32x4){0.f, 0.f, 0.f, 0.f};
            for (int g = 0; g < 28; ++g) sacc += red[(g * 9 + r) * 18 + cc];
            *(f32x4*)((float*)(p.ws + WS_MODS) + ((size_t)l * 9 + r) * NMOD + j0 + 4 * cc) = sacc + *(const f32x4*)(p.ada_b + (size_t)l * NMOD + j0 + 4 * cc);
        }
        __syncthreads();
    }
}

DI void phase_norm(const float* src_ctx, const float* src_lat, bf16_t* HB, const float* mods_l, const float* g, int kshift, int row_lo, const bf16_t* slab, int nsl, float* xc_out) {
    const int tid = tid_op(); const int lane = tid & 63, gw = bid_op() * 8 + (tid >> 6), nw = gridDim.x * 8;
    for (int row = row_lo + gw; row < T; row += nw) {
        const float* xr = xrow_src(src_ctx, src_lat, row);
        const float* md = mods_l + (size_t)mod_row(row) * NMOD;
        f32x4 v[4]; float ss = 0.f;
#pragma unroll
        for (int i = 0; i < 4; ++i) {
            v[i] = *(const f32x4*)(xr + i * 256 + lane * 4);
            if (slab != nullptr && row < TCTX) {
                for (int sl = 0; sl < nsl; ++sl) { const u32x2 q = *(const u32x2*)(slab + ((size_t)sl * TCTX + row) * D + i * 256 + lane * 4);
                    v[i][0] += bf2f((bf16_t)(q[0] & 0xffffu)); v[i][1] += bf2f((bf16_t)(q[0] >> 16)); v[i][2] += bf2f((bf16_t)(q[1] & 0xffffu)); v[i][3] += bf2f((bf16_t)(q[1] >> 16)); }
                *(f32x4*)(xc_out + (size_t)row * D + i * 256 + lane * 4) = v[i];
            }
            ss += v[i][0] * v[i][0] + v[i][1] * v[i][1] + v[i][2] * v[i][2] + v[i][3] * v[i][3];
        }
        ss = wave_sum(ss);
        const float rstd = rsqrtf(ss * (1.f / D) + EPS);
#pragma unroll
        for (int i = 0; i < 4; ++i) {
            const int cidx = i * 256 + lane * 4;
            const f32x4 gg = *(const f32x4*)(g + cidx), sh = *(const f32x4*)(md + kshift * D + cidx), sc = *(const f32x4*)(md + (kshift + 1) * D + cidx);
            const f32x4 h = v[i] * rstd * gg * (sc + 1.f) + sh;
            u32x2 o; o[0] = pack2(h[0], h[1]); o[1] = pack2(h[2], h[3]);
            *(u32x2*)(HB + (size_t)row * D + cidx) = o;
        }
    }
}

DI void phase_final(float* X, const float* g) {
    const int tid = tid_op(); const int lane = tid & 63, gw = bid_op() * 8 + (tid >> 6), nw = gridDim.x * 8;
    for (int row = gw; row < TLAT; row += nw) {
        float* xr = X + (size_t)row * D;
        f32x4 v[4]; float ss = 0.f;
#pragma unroll
        for (int i = 0; i < 4; ++i) { v[i] = *(const f32x4*)(xr + i * 256 + lane * 4); ss += v[i][0] * v[i][0] + v[i][1] * v[i][1] + v[i][2] * v[i][2] + v[i][3] * v[i][3]; }
        ss = wave_sum(ss);
        const float rstd = rsqrtf(ss * (1.f / D) + EPS);
#pragma unroll
        for (int i = 0; i < 4; ++i) { const int cidx = i * 256 + lane * 4; *(f32x4*)(xr + cidx) = v[i] * rstd * *(const f32x4*)(g + cidx); }
    }
}

DI void phase_e0(const Params& p, unsigned char* smem) {
    const int tid = tid_op();
    bf16_t* P = (bf16_t*)(p.ws + WS_PH);
    bf16_t* QKC = (bf16_t*)(p.ws + WS_SC);
    float* tab = (float*)smem;
    for (int i = tid; i < 1024; i += NTHREADS) {
        const int pos = i >> 4, f = i & 15;
        const float inv = powf(10000.0f, -(float)f * (2.0f / 32.0f));
        const float ang = (float)pos * inv;
        float s, c; sincosf(ang, &s, &c);
        tab[2 * i] = c; tab[2 * i + 1] = s;
    }
    __syncthreads();
    const int rsub = tid >> 6, t64 = tid & 63;
    const int ch0 = t64 * 8;
    float w0[8], w1[8], w2[8], cb[8];
#pragma unroll
    for (int j = 0; j < 8; ++j) { w0[j] = p.conv_w[ch0 + j]; w1[j] = p.conv_w[512 + ch0 + j]; w2[j] = p.conv_w[1024 + ch0 + j]; cb[j] = p.conv_b[ch0 + j]; }
    const float qs = ch0 < 256 ? 0.125f : 1.0f;
    const int grp = t64 >> 1, half = t64 & 1;
    const int cA = grp * 32 + half * 8;
    const int which = grp >> 4, axis = grp & 1;
    const float sc = which == 0 ? 0.18033688011112042f : 1.0f;
    for (int chunk = bid_op(); chunk < T / 8; chunk += gridDim.x) {
        const int row0 = chunk * 8;
        const bool isctx = row0 < TCTX;
        const int seq0 = isctx ? (row0 & 255) : ((row0 - TCTX) & 4095);
        const int seqlen = isctx ? CTXL : SEQ;
        {
            const int i = rsub, row = row0 + i, t = seq0 + i;
            {
                const bf16_t* src = P + (size_t)row * PLD + 1536 + ch0;
                const u32x4 z = (u32x4){0u, 0u, 0u, 0u};
                const u32x4 xm = t > 0 ? *(const u32x4*)(src - PLD) : z;
                const u32x4 x0 = *(const u32x4*)src;
                const u32x4 xp = t + 1 < seqlen ? *(const u32x4*)(src + PLD) : z;
                u32x4 o;
#pragma unroll
                for (int j = 0; j < 4; ++j) {
                    const float y0 = w0[2 * j] * bf2f((bf16_t)(xm[j] & 0xffffu)) + w1[2 * j] * bf2f((bf16_t)(x0[j] & 0xffffu)) + w2[2 * j] * bf2f((bf16_t)(xp[j] & 0xffffu)) + cb[2 * j];
                    const float y1 = w0[2 * j + 1] * bf2f((bf16_t)(xm[j] >> 16)) + w1[2 * j + 1] * bf2f((bf16_t)(x0[j] >> 16)) + w2[2 * j + 1] * bf2f((bf16_t)(xp[j] >> 16)) + cb[2 * j + 1];
                    o[j] = pack2(siluf(y0) * qs, siluf(y1) * qs);
                }
                *(u32x4*)(QKC + (size_t)row * 512 + ch0) = o;
            }
            if (!isctx && which == 1) {
                bf16_t* r = P + (size_t)row * PLD + cA;
                const u32x4 a = *(const u32x4*)r, b = *(const u32x4*)(r + 16);
                const int pos = axis == 0 ? (t >> 6) : (t & 63);
                u32x4 oa, ob;
#pragma unroll
                for (int j = 0; j < 4; ++j) {
                    float a0 = bf2f((bf16_t)(a[j] & 0xffffu)), a1 = bf2f((bf16_t)(a[j] >> 16)), b0 = bf2f((bf16_t)(b[j] & 0xffffu)), b1 = bf2f((bf16_t)(b[j] >> 16));
                    if (!isctx) {
                        const int f0 = half * 8 + 2 * j;
                        const float c0 = tab[2 * (pos * 16 + f0)], s0 = tab[2 * (pos * 16 + f0) + 1], c1 = tab[2 * (pos * 16 + f0 + 1)], s1 = tab[2 * (pos * 16 + f0 + 1) + 1];
                        const float na0 = a0 * c0 - b0 * s0, nb0 = b0 * c0 + a0 * s0, na1 = a1 * c1 - b1 * s1, nb1 = b1 * c1 + a1 * s1;
                        a0 = na0; b0 = nb0; a1 = na1; b1 = nb1;
                    }
                    oa[j] = pack2(a0 * sc, a1 * sc); ob[j] = pack2(b0 * sc, b1 * sc);
                }
                *(u32x4*)r = oa; *(u32x4*)(r + 16) = ob;
            }
        }
    }
}

DI void attn_item(const Params& p, int item, unsigned char* smem, float lam) {
    const int tid = tid_op(), wid = tid >> 6, lane = tid & 63, fr = lane & 15, fq = lane >> 4;
    const bf16_t* P = (const bf16_t*)(p.ws + WS_PH);
    bf16_t* HB = (bf16_t*)(p.ws + WS_HB);
    constexpr int KLD = 136, VLD = 144, BUF = 64 * KLD + 64 * VLD;
    bf16_t* L0 = (bf16_t*)smem;
    int b, h, qrow0, nkt; bool isctx = item >= 1024;
    if (!isctx) { b = item >> 7; h = (item >> 5) & 3; const int qb = item & 31; qrow0 = TCTX + b * SEQ + qb * 128; nkt = 68; }
    else { const int it = item - 1024; b = it >> 3; h = (it >> 1) & 3; const int qb = it & 1; qrow0 = b * CTXL + qb * 128; nkt = 4; }
    const int qrow = qrow0 + wid * 16 + fr;
    bf16x8 Qf[2][2];
    {
        const int tq = (qrow - TCTX) & 4095;
        const float qsc = 0.18033688011112042f;
#pragma unroll
        for (int c = 0; c < 2; ++c)
#pragma unroll
            for (int ks = 0; ks < 2; ++ks) {
                const u32x4 raw = *(const u32x4*)(P + (size_t)qrow * PLD + h * 128 + c * 64 + ks * 32 + 8 * fq);
                u32x4 outw;
#pragma unroll
                for (int w2 = 0; w2 < 4; ++w2) {
                    const unsigned mine = raw[w2], other = (unsigned)__shfl_xor((int)raw[w2], 32);
                    float m0 = bf2f((bf16_t)(mine & 0xffffu)), m1 = bf2f((bf16_t)(mine >> 16));
                    if (!isctx) {
                        const float o0 = bf2f((bf16_t)(other & 0xffffu)), o1 = bf2f((bf16_t)(other >> 16));
                        const int fi = 8 * (fq & 1) + 2 * w2;
                        const int pos = ks == 0 ? (tq >> 6) : (tq & 63);
                        const f32x4 cs4 = *(const f32x4*)((const float*)(p.ws + WS_ROPE) + 2 * (pos * 16 + fi));
                        const float c0 = cs4[0], s0 = cs4[1], c1 = cs4[2], s1 = cs4[3];
                        m0 = fq < 2 ? m0 * c0 - o0 * s0 : m0 * c0 + o0 * s0;
                        m1 = fq < 2 ? m1 * c1 - o1 * s1 : m1 * c1 + o1 * s1;
                    }
                    outw[w2] = pack2(m0 * qsc, m1 * qsc);
                }
                Qf[c][ks] = __builtin_bit_cast(bf16x8, outw);
            }
    }
    f32x4 O[2][8];
#pragma unroll
    for (int c = 0; c < 2; ++c)
#pragma unroll
        for (int e = 0; e < 8; ++e) O[c][e] = (f32x4){0.f, 0.f, 0.f, 0.f};
    float mrun[2] = {-1e30f, -1e30f};
    f32x4 Lacc[2] = {(f32x4){0.f, 0.f, 0.f, 0.f}, (f32x4){0.f, 0.f, 0.f, 0.f}};
    const bf16x8 ones = (bf16x8){0x3F80, 0x3F80, 0x3F80, 0x3F80, 0x3F80, 0x3F80, 0x3F80, 0x3F80};
    const int skey[2] = {tid >> 4, (tid >> 4) + 32}; const int sc8 = (tid & 15) * 8;
    u32x4 kreg[2], vreg[2];
    auto krow = [&](int kt, int key) -> size_t { return (size_t)(kt < 4 ? b * CTXL + kt * 64 + key : TCTX + b * SEQ + (kt - 4) * 64 + key); };
    auto prefetch = [&](int kt) {
#pragma unroll
        for (int i = 0; i < 2; ++i) {
            const bf16_t* rp = P + krow(kt, skey[i]) * PLD + h * 128 + sc8;
            kreg[i] = *(const u32x4*)(rp + 512);
            vreg[i] = *(const u32x4*)(rp + 1024);
        }
    };
    auto stage = [&](int buf) {
        bf16_t* Kb = L0 + buf * BUF; bf16_t* Vb = Kb + 64 * KLD;
#pragma unroll
        for (int i = 0; i < 2; ++i) { *(u32x4*)(Kb + skey[i] * KLD + sc8) = kreg[i]; *(u32x4*)(Vb + skey[i] * VLD + sc8) = vreg[i]; }
    };
    prefetch(0); stage(0);
    if (nkt > 1) prefetch(1);
    lds_barrier();
    for (int kt = 0; kt < nkt; ++kt) {
        if (kt + 1 < nkt) stage((kt + 1) & 1);
        if (kt + 2 < nkt) prefetch(kt + 2);
        const bf16_t* Ks = L0 + (kt & 1) * BUF; const bf16_t* Vs = Ks + 64 * KLD;
        bf16x8 pf[2][2];
#pragma unroll
        for (int c = 0; c < 2; ++c) {
            f32x4 s[4];
#pragma unroll
            for (int sub = 0; sub < 4; ++sub) {
                s[sub] = (f32x4){0.f, 0.f, 0.f, 0.f};
#pragma unroll
                for (int ks = 0; ks < 2; ++ks) s[sub] = mfma16(ldfrag(Ks, KLD, sub * 16 + fr, c * 64 + ks * 32 + 8 * fq), Qf[c][ks], s[sub]);
            }
            float mx = fmaxf(fmaxf(s[0][0], s[0][1]), fmaxf(s[0][2], s[0][3]));
#pragma unroll
            for (int sub = 1; sub < 4; ++sub) mx = fmaxf(mx, fmaxf(fmaxf(s[sub][0], s[sub][1]), fmaxf(s[sub][2], s[sub][3])));
            mx = fmaxf(mx, __shfl_xor(mx, 16)); mx = fmaxf(mx, __shfl_xor(mx, 32));
            if (__builtin_amdgcn_ballot_w64(mx > mrun[c] + 8.0f) != 0ull) {
                const float mnew = fmaxf(mrun[c], mx), alpha = __builtin_amdgcn_exp2f(mrun[c] - mnew);
                mrun[c] = mnew; Lacc[c] *= alpha;
#pragma unroll
                for (int e = 0; e < 8; ++e) O[c][e] *= alpha;
            }
            const float mref = mrun[c];
#pragma unroll
            for (int sub = 0; sub < 4; ++sub)
#pragma unroll
                for (int j = 0; j < 4; ++j) s[sub][j] = __builtin_amdgcn_exp2f(s[sub][j] - mref);
#pragma unroll
            for (int s2 = 0; s2 < 2; ++s2) {
                u32x4 pk;
                pk[0] = pack2(s[2 * s2][0], s[2 * s2][1]); pk[1] = pack2(s[2 * s2][2], s[2 * s2][3]);
                pk[2] = pack2(s[2 * s2 + 1][0], s[2 * s2 + 1][1]); pk[3] = pack2(s[2 * s2 + 1][2], s[2 * s2 + 1][3]);
                pf[c][s2] = __builtin_bit_cast(bf16x8, pk);
            }
        }
        const int voff = (4 * fq + (fr >> 2)) * VLD + 4 * (fr & 3);
#pragma unroll
        for (int e = 0; e < 8; ++e)
#pragma unroll
            for (int s2 = 0; s2 < 2; ++s2) {
                const s16x4 lo = __builtin_amdgcn_ds_read_tr16_b64_v4i16((LAS s16x4*)(LAS unsigned char*)(unsigned char*)(Vs + voff + (32 * s2) * VLD + 16 * e));
                const s16x4 hi = __builtin_amdgcn_ds_read_tr16_b64_v4i16((LAS s16x4*)(LAS unsigned char*)(unsigned char*)(Vs + voff + (32 * s2 + 16) * VLD + 16 * e));
                const bf16x8 vf = __builtin_shufflevector(lo, hi, 0, 1, 2, 3, 4, 5, 6, 7);
                O[0][e] = mfma16(vf, pf[0][s2], O[0][e]);
                O[1][e] = mfma16(vf, pf[1][s2], O[1][e]);
            }
#pragma unroll
        for (int s2 = 0; s2 < 2; ++s2) { Lacc[0] = mfma16(ones, pf[0][s2], Lacc[0]); Lacc[1] = mfma16(ones, pf[1][s2], Lacc[1]); }
        lds_barrier();
    }
    const float i0 = 1.f / Lacc[0][0], i1 = lam / Lacc[1][0];
    float ss = 0.f;
#pragma unroll
    for (int e = 0; e < 8; ++e)
#pragma unroll
        for (int j = 0; j < 4; ++j) { const float v = O[0][e][j] * i0 - O[1][e][j] * i1; O[0][e][j] = v; ss += v * v; }
    ss += __shfl_xor(ss, 16); ss += __shfl_xor(ss, 32);
    const float rstd = rsqrtf(ss * (1.f / 128.f) + EPS) * 0.8f;
#pragma unroll
    for (int e = 0; e < 8; ++e) {
        const f32x4 g = *(const f32x4*)(p.diff_norm_g + e * 16 + 4 * fq);
        u32x2 o; o[0] = pack2(O[0][e][0] * rstd * g[0], O[0][e][1] * rstd * g[1]); o[1] = pack2(O[0][e][2] * rstd * g[2], O[0][e][3] * rstd * g[3]);
        *(u32x2*)(HB + (size_t)qrow * D + h * 128 + e * 16 + 4 * fq) = o;
    }
}

DI void mlstm_scan(const Params& p, int sb, unsigned char* smem) {
    const int tid = tid_op(), wid = tid >> 6, lane = tid & 63, fr = lane & 15, fq = lane >> 4;
    const int b = sb >> 3, h = (sb >> 1) & 3, dir = sb & 1;
    const bf16_t* P = (const bf16_t*)(p.ws + WS_PH);
    const bf16_t* QKC = (const bf16_t*)(p.ws + WS_SC);
    bf16_t* MO = (bf16_t*)(p.ws + WS_SC) + (size_t)(1 + dir) * T * 512;
    const float* GT = (const float*)(p.ws + WS_GATES);
    bf16_t* Qs = (bf16_t*)smem; bf16_t* Ks = Qs + 64 * 72; bf16_t* KwT = Ks + 64 * 72; bf16_t* VT = KwT + 64 * 72  ; bf16_t* Sw = VT + 64 * 136; bf16_t* Cb = Sw + 64 * 72;
    float* fa = (float*)(Cb + 2 * 128 * 72);
    float* s_bc = fa; float* s_ic = fa + 64; float* s_mt = fa + 128; float* s_wi = fa + 192; float* s_wk = fa + 256; float* s_nv = fa + 320; float* s_qn = fa + 384; float* s_rsp = fa + 448;   float* s_sc = fa + 704;
    for (int i = tid; i < 2 * 128 * 72; i += NTHREADS) Cb[i] = 0;
    if (tid < 64) s_nv[tid] = 0.f;
    f32x4 Cacc[4] = {(f32x4){0.f, 0.f, 0.f, 0.f}, (f32x4){0.f, 0.f, 0.f, 0.f}, (f32x4){0.f, 0.f, 0.f, 0.f}, (f32x4){0.f, 0.f, 0.f, 0.f}};
    float mstate = 0.f;
    const int tr = wid >> 1, tc0 = (wid & 1) * 2;
    auto chunk_row0 = [&](int ci) -> int { return ci < 4 ? b * CTXL + (dir ? 3 - ci : ci) * 64 : TCTX + b * SEQ + (dir ? 63 - (ci - 4) : ci - 4) * 64; };
    auto pos_row = [&](int r0, int i) -> int { return r0 + (dir ? 63 - i : i); };
    u32x4 qreg, kreg, vreg[2]; float gi = 0.f, gf = 0.f;
    const int vrow[2] = {tid >> 4, (tid >> 4) + 32}; const int vcol = (tid & 15) * 8;
    const int qi = tid >> 3, qc8 = (tid & 7) * 8;
    auto prefetch = [&](int ci) {
        const int r0 = chunk_row0(ci);
        qreg = *(const u32x4*)(QKC + (size_t)pos_row(r0, qi) * 512 + h * 64 + qc8);
        kreg = *(const u32x4*)(QKC + (size_t)pos_row(r0, qi) * 512 + 256 + h * 64 + qc8);
        vreg[0] = *(const u32x4*)(P + (size_t)pos_row(r0, vrow[0]) * PLD + 2048 + h * 128 + vcol); vreg[1] = *(const u32x4*)(P + (size_t)pos_row(r0, vrow[1]) * PLD + 2048 + h * 128 + vcol);
        if (tid < 64) { const float* g = GT + (size_t)pos_row(r0, tid) * 16; gi = g[dir * 4 + h]; gf = g[(2 + dir) * 4 + h]; }
    };
    prefetch(0);
    int cur = 0;
    for (int ci = 0; ci < 68; ++ci) {
        const int r0 = chunk_row0(ci);
        lds_barrier();
        *(u32x4*)(Qs + qi * 72 + qc8) = qreg;
        *(u32x4*)(Ks + qi * 72 + qc8) = kreg;
        *(u32x4*)(VT + vrow[0] * 136 + vcol) = vreg[0]; *(u32x4*)(VT + vrow[1] * 136 + vcol) = vreg[1];
        if (wid == 0) {
            const float f = logsigf(gf);
            float bc = f;
            for (int o = 1; o < 64; o <<= 1) { const float t = __shfl_up(bc, o); if (lane >= o) bc += t; }
            const float bl = __shfl(bc, 63);
            float pm = gi - bc;
            for (int o = 1; o < 64; o <<= 1) { const float t = __shfl_up(pm, o); if (lane >= o) pm = fmaxf(pm, t); }
            const float mt = bc + fmaxf(mstate, pm);
            const float wi = __expf(bc + mstate - mt);
            const float g = bl - bc + gi;
            const float gmax = wave_max(g);
            const float mnew = fmaxf(bl + mstate, gmax);
            const float wk = __expf(g - mnew);
            const float decay = __expf(bl + mstate - mnew);
            s_bc[lane] = bc; s_ic[lane] = gi; s_mt[lane] = mt; s_wi[lane] = wi; s_wk[lane] = wk;
            if (lane == 0) s_sc[0] = decay;
            mstate = mnew;
        }
        lds_barrier();
        if (ci + 1 < 68) prefetch(ci + 1);
        {
            const int s = tid & 63, d8 = (tid >> 6) * 8; const float wk = s_wk[s];
            const int sslot = 32 * (s >> 5) + 8 * ((s >> 2) & 3) + 4 * ((s >> 4) & 1) + (s & 3);
            const u32x4 kv = *(const u32x4*)(Ks + s * 72 + d8);
#pragma unroll
            for (int j = 0; j < 4; ++j) { KwT[(d8 + 2 * j) * 72 + sslot] = f2bf(bf2f((bf16_t)(kv[j] & 0xffffu)) * wk); KwT[(d8 + 2 * j + 1) * 72 + sslot] = f2bf(bf2f((bf16_t)(kv[j] >> 16)) * wk); }
        }
        {
            const int t = tid >> 3, part = tid & 7; float a = 0.f;
#pragma unroll
            for (int j = 0; j < 8; ++j) a += bf2f(Qs[t * 72 + part * 8 + j]) * s_nv[part * 8 + j];
            a += __shfl_xor(a, 1); a += __shfl_xor(a, 2); a += __shfl_xor(a, 4);
            if (part == 0) s_qn[t] = a;
        }
#pragma unroll
        for (int k2 = 0; k2 < 2; ++k2) {
            const int tc = tc0 + k2; const int t = tr * 16 + fr;
            f32x4 a = (f32x4){0.f, 0.f, 0.f, 0.f};
            if (tc <= tr) {
#pragma unroll
                for (int ks = 0; ks < 2; ++ks) a = mfma16(ldfrag(Ks, 72, tc * 16 + fr, ks * 32 + 8 * fq), ldfrag(Qs, 72, t, ks * 32 + 8 * fq), a);
                const float bt = s_bc[t] - s_mt[t];
#pragma unroll
                for (int j = 0; j < 4; ++j) { const int s = tc * 16 + 4 * fq + j; a[j] = (s <= t) ? a[j] * __expf(bt - s_bc[s] + s_ic[s]) : 0.f; }
            }
            float rs = a[0] + a[1] + a[2] + a[3];
            rs += __shfl_xor(rs, 16); rs += __shfl_xor(rs, 32);
            if (fq == 0) s_rsp[tc * 64 + t] = rs;
            u32x2 o; o[0] = pack2(a[0], a[1]); o[1] = pack2(a[2], a[3]);
            *(u32x2*)(Sw + t * 72 + 32 * (tc >> 1) + 8 * fq + 4 * (tc & 1)) = o;
        }
        lds_barrier();
        const float decay = s_sc[0];
        const bf16_t* Cc = Cb + cur * 128 * 72; bf16_t* Cn = Cb + (cur ^ 1) * 128 * 72;
        auto vfrag = [&](int et, int ks) -> bf16x8 {
            const bf16_t* base = VT + (32 * ks + 4 * fq + (fr >> 2)) * 136 + 16 * et + 4 * (fr & 3);
            const s16x4 lo = __builtin_amdgcn_ds_read_tr16_b64_v4i16((LAS s16x4*)(LAS unsigned char*)(unsigned char*)base);
            const s16x4 hi = __builtin_amdgcn_ds_read_tr16_b64_v4i16((LAS s16x4*)(LAS unsigned char*)(unsigned char*)(base + 16 * 136));
            return __builtin_shufflevector(lo, hi, 0, 1, 2, 3, 4, 5, 6, 7);
        };
        const int ec0 = (wid & 1) * 4;
        {
            const int t = tr * 16 + fr;
            const float wi = s_wi[t];
            const float den = s_rsp[t] + s_rsp[64 + t] + s_rsp[128 + t] + s_rsp[192 + t] + wi * s_qn[t];
            const float dn = 1.f / fmaxf(fabsf(den), __expf(-s_mt[t]));
#pragma unroll
            for (int k4 = 0; k4 < 4; ++k4) {
                const int tc = ec0 + k4;
                f32x4 a1 = (f32x4){0.f, 0.f, 0.f, 0.f}, a2 = (f32x4){0.f, 0.f, 0.f, 0.f};
#pragma unroll
                for (int ks = 0; ks < 2; ++ks) {
                    a1 = mfma16(vfrag(tc, ks), ldfrag(Sw, 72, t, ks * 32 + 8 * fq), a1);
                    a2 = mfma16(ldfrag(Cc, 72, tc * 16 + fr, ks * 32 + 8 * fq), ldfrag(Qs, 72, t, ks * 32 + 8 * fq), a2);
                }
                u32x2 o; o[0] = pack2((a1[0] + wi * a2[0]) * dn, (a1[1] + wi * a2[1]) * dn); o[1] = pack2((a1[2] + wi * a2[2]) * dn, (a1[3] + wi * a2[3]) * dn);
                *(u32x2*)(MO + (size_t)pos_row(r0, t) * 512 + h * 128 + tc * 16 + 4 * fq) = o;
            }
        }
#pragma unroll
        for (int k4 = 0; k4 < 4; ++k4) {
            const int tc = ec0 + k4;
            f32x4 a = Cacc[k4] * decay;
#pragma unroll
            for (int ks = 0; ks < 2; ++ks) a = mfma16(ldfrag(KwT, 72, tr * 16 + fr, ks * 32 + 8 * fq), vfrag(tc, ks), a);
            Cacc[k4] = a;
            u32x2 o; o[0] = pack2(a[0], a[1]); o[1] = pack2(a[2], a[3]);
            *(u32x2*)(Cn + (tc * 16 + fr) * 72 + tr * 16 + 4 * fq) = o;
        }
        {
            const int d = tid >> 3, part = tid & 7; float a = 0.f;
#pragma unroll
            for (int j = 0; j < 8; ++j) { const int s = part * 8 + j; a += s_wk[s] * bf2f(Ks[s * 72 + d]); }
            a += __shfl_xor(a, 1); a += __shfl_xor(a, 2); a += __shfl_xor(a, 4);
            if (part == 0) s_nv[d] = decay * s_nv[d] + a;
        }
        cur ^= 1;
    }
    lds_barrier();
}

DI void phase_a0(const Params& p, unsigned char* smem, int rep) {
    __shared__ int s_item;
    float l1 = 0.f, l2 = 0.f;
    for (int i = 0; i < 64; ++i) { l1 += p.diff_lambda[i] * p.diff_lambda[64 + i]; l2 += p.diff_lambda[128 + i] * p.diff_lambda[192 + i]; }
    const float lam = expf(l1) - expf(l2) + 0.2f;
    #ifdef A0_MODE
    if (rep == 0 || (A0_MODE & 1))
#endif
    { const int bb = bid_op(); if (bb < 64) mlstm_scan(p, bb, smem); }
#ifdef A0_MODE
    if (rep == 1 && !(A0_MODE & 2)) return;
#endif
    unsigned* ctr = (unsigned*)(p.ws + WS_CTL) + 3584 + 1024 * rep;
    const unsigned myx = ((unsigned)__builtin_amdgcn_s_getreg((3 << 11) | 20)) & 7u;
    for (unsigned k = 0; k < 8; ++k) {
        const unsigned x = (myx + k) & 7u;
        for (;;) {
            __syncthreads();
            if (tid_op() == 0) s_item = (int)atomicAdd(ctr + 64 * x, 1u);
            __syncthreads();
            const int j = s_item;
            if (j >= 136) break;
            const int G = (int)x * 4 + j / 34, r = j % 34;
            const int item = r < 32 ? G * 32 + r : 1024 + G * 2 + (r - 32);
            attn_item(p, item, smem, lam);
        }
    }
}

DI void phase_m0(const Params& p) {
    const int tid = tid_op(); const int lane = tid & 63, gw = bid_op() * 8 + (tid >> 6), nw = gridDim.x * 8;
    const bf16_t* P = (const bf16_t*)(p.ws + WS_PH);
    const bf16_t* MF = (const bf16_t*)(p.ws + WS_SC) + (size_t)T * 512; const bf16_t* MB = MF + (size_t)T * 512;
    bf16_t* HB = (bf16_t*)(p.ws + WS_HB);
    for (int row = gw; row < T; row += nw) {
        const int c0 = lane * 8;
        const u32x4 a = *(const u32x4*)(MF + (size_t)row * 512 + c0), bb = *(const u32x4*)(MB + (size_t)row * 512 + c0);
        const u32x4 op = *(const u32x4*)(P + (size_t)row * PLD + 2560 + c0);
        float v[8]; float ss = 0.f;
#pragma unroll
        for (int j = 0; j < 4; ++j) {
            v[2 * j] = bf2f((bf16_t)(a[j] & 0xffffu)) + bf2f((bf16_t)(bb[j] & 0xffffu)); v[2 * j + 1] = bf2f((bf16_t)(a[j] >> 16)) + bf2f((bf16_t)(bb[j] >> 16));
            ss += v[2 * j] * v[2 * j] + v[2 * j + 1] * v[2 * j + 1];
        }
        ss += __shfl_xor(ss, 1); ss += __shfl_xor(ss, 2); ss += __shfl_xor(ss, 4); ss += __shfl_xor(ss, 8);
        const float rstd = rsqrtf(ss * (1.f / 128.f) + EPS);
        u32x4 o;
#pragma unroll
        for (int j = 0; j < 4; ++j) {
            const float o0 = v[2 * j] * rstd * p.ml_norm_g[c0 + 2 * j] * sigmoidf(bf2f((bf16_t)(op[j] & 0xffffu)));
            const float o1 = v[2 * j + 1] * rstd * p.ml_norm_g[c0 + 2 * j + 1] * sigmoidf(bf2f((bf16_t)(op[j] >> 16)));
            o[j] = pack2(o0, o1);
        }
        *(u32x4*)(HB + (size_t)row * D + 512 + c0) = o;
    }
}

DI void phase_e1(const Params& p, unsigned char* smem) {
    const int tid = tid_op();
    const bf16_t* P = (const bf16_t*)(p.ws + WS_PH);
    bf16_t* LA = (bf16_t*)(p.ws + WS_HB);
    float* lrs = (float*)smem;
    const int c2 = (tid & 255) * 2, rh = tid >> 8;
    float wf[16][2], wb[16][2];
#pragma unroll
    for (int r = 0; r < 16; ++r) { wf[r][0] = p.gla_w_gate[r * 512 + c2]; wf[r][1] = p.gla_w_gate[r * 512 + c2 + 1]; wb[r][0] = p.gla_w_gate[(16 + r) * 512 + c2]; wb[r][1] = p.gla_w_gate[(16 + r) * 512 + c2 + 1]; }
    const float bf0 = p.gla_b_gate[c2], bf1 = p.gla_b_gate[c2 + 1], bb0 = p.gla_b_gate[512 + c2], bb1 = p.gla_b_gate[512 + c2 + 1];
    for (int chunk = bid_op(); chunk < T / 16; chunk += gridDim.x) {
        const int row0 = chunk * 16;
        __syncthreads();
        if (tid < 128) { const int rr = tid >> 3, c4 = (tid & 7) * 4;
          const u32x2 v = *(const u32x2*)(P + (size_t)(row0 + rr) * PLD + 3072 + c4);
          lrs[rr * 32 + c4] = bf2f((bf16_t)(v[0] & 0xffffu)); lrs[rr * 32 + c4 + 1] = bf2f((bf16_t)(v[0] >> 16)); lrs[rr * 32 + c4 + 2] = bf2f((bf16_t)(v[1] & 0xffffu)); lrs[rr * 32 + c4 + 3] = bf2f((bf16_t)(v[1] >> 16)); }
        __syncthreads();
#pragma unroll 2
        for (int it = 0; it < 8; ++it) {
            const int i = 2 * it + rh;
            float zf0 = bf0, zf1 = bf1, zb0 = bb0, zb1 = bb1;
#pragma unroll
            for (int r = 0; r < 16; ++r) { const float a = lrs[i * 32 + r], b = lrs[i * 32 + 16 + r]; zf0 += a * wf[r][0]; zf1 += a * wf[r][1]; zb0 += b * wb[r][0]; zb1 += b * wb[r][1]; }
            *(unsigned*)(LA + (size_t)(row0 + i) * 512 + c2) = pack2(logsigf(zf0) * (1.f / 16.f), logsigf(zf1) * (1.f / 16.f));
            *(unsigned*)(LA + (size_t)T * 512 + (size_t)(row0 + i) * 512 + c2) = pack2(logsigf(zb0) * (1.f / 16.f), logsigf(zb1) * (1.f / 16.f));
        }
    }
}

DI void phase_s1(const Params& p, unsigned char* smem) {
    const int tid = tid_op(), wid = tid >> 6, lane = tid & 63, fr = lane & 15, fq = lane >> 4;
    const bf16_t* P = (const bf16_t*)(p.ws + WS_PH);
    bf16_t* Qe = (bf16_t*)smem;
    bf16_t* Ke = Qe + 64 * 136;
    bf16_t* LAs = Ke + 64 * 136;
    bf16_t* KdT = LAs + 64 * 144;
    bf16_t* VT = KdT + 128 * 72;
    bf16_t* Am = VT + 64 * 72;
    bf16_t* St = Am + 64 * 72;
    float* s_bl = (float*)(St + 2 * 64 * 136);
    for (int sb = bid_op(); sb < 256; sb += gridDim.x) {
        const int b = sb >> 5, h = (sb >> 3) & 3, dir = (sb >> 2) & 1, es = sb & 3;
        const bf16_t* LA = (const bf16_t*)(p.ws + WS_HB) + (size_t)dir * T * 512;
        bf16_t* OO = (bf16_t*)(p.ws + WS_SC) + (size_t)dir * T * D;
        lds_barrier();
        for (int i = tid; i < 2 * 64 * 136; i += NTHREADS) St[i] = 0;
        f32x4 Sacc[4];
#pragma unroll
        for (int k = 0; k < 4; ++k) Sacc[k] = (f32x4){0.f, 0.f, 0.f, 0.f};
        auto chunk_row0 = [&](int ci) -> int { return ci < 4 ? b * CTXL + (dir ? 3 - ci : ci) * 64 : TCTX + b * SEQ + (dir ? 63 - (ci - 4) : ci - 4) * 64; };
        auto pos_row = [&](int r0, int i) -> int { return r0 + (dir ? 63 - i : i); };
        const int pr[2] = {tid >> 4, (tid >> 4) + 32}; const int pc = (tid & 15) * 8; const int vr = tid >> 3, vc = (tid & 7) * 8;
        u32x4 qA[2], kA[2], lA[2], vA, qB[2], kB[2], lB[2], vB;
        auto prefetch = [&](int ci, u32x4 (&qreg)[2], u32x4 (&kreg)[2], u32x4 (&lreg)[2], u32x4& vreg) {
            const int r0p = chunk_row0(ci);
#pragma unroll
            for (int i = 0; i < 2; ++i) {
                const size_t row = (size_t)pos_row(r0p, pr[i]);
                qreg[i] = *(const u32x4*)(P + row * PLD + h * 128 + pc);
                kreg[i] = *(const u32x4*)(P + row * PLD + 512 + h * 128 + pc);
                lreg[i] = *(const u32x4*)(LA + row * 512 + h * 128 + pc);
            }
            vreg = *(const u32x4*)(P + (size_t)pos_row(r0p, vr) * PLD + 1024 + h * 256 + es * 64 + vc);
        };
        prefetch(0, qA, kA, lA, vA);
        int cur = 0;
        auto step = [&](int ci, u32x4 (&qreg)[2], u32x4 (&kreg)[2], u32x4 (&lreg)[2], u32x4& vreg, u32x4 (&qn)[2], u32x4 (&kn)[2], u32x4 (&ln)[2], u32x4& vn) {
            const int r0 = chunk_row0(ci);
            lds_barrier();
            if (ci + 1 < 68) prefetch(ci + 1, qn, kn, ln, vn);
#pragma unroll
            for (int i = 0; i < 2; ++i) {
                *(u32x4*)(Qe + pr[i] * 136 + pc) = qreg[i];
                *(u32x4*)(Ke + pr[i] * 136 + pc) = kreg[i];
                *(u32x4*)(LAs + pr[i] * 144 + pc) = lreg[i];
            }
            *(u32x4*)(VT + vr * 72 + vc) = vreg;
            lds_barrier();
            {
                bf16x8 laf[2];
#pragma unroll
                for (int ks = 0; ks < 2; ++ks) {
                    const bf16_t* base = LAs + (32 * ks + 4 * fq + (fr >> 2)) * 144 + 16 * wid + 4 * (fr & 3);
                    const s16x4 lo = __builtin_amdgcn_ds_read_tr16_b64_v4i16((LAS s16x4*)(LAS unsigned char*)(unsigned char*)base);
                    const s16x4 hi = __builtin_amdgcn_ds_read_tr16_b64_v4i16((LAS s16x4*)(LAS unsigned char*)(unsigned char*)(base + 16 * 144));
                    laf[ks] = __builtin_shufflevector(lo, hi, 0, 1, 2, 3, 4, 5, 6, 7);
                }
                const bf16x8 ones = (bf16x8){0x3F80, 0x3F80, 0x3F80, 0x3F80, 0x3F80, 0x3F80, 0x3F80, 0x3F80};
                f32x4 blt = (f32x4){0.f, 0.f, 0.f, 0.f};
#pragma unroll
                for (int ks = 0; ks < 2; ++ks) blt = mfma16(laf[ks], ones, blt);
                float ebl[4];
#pragma unroll
                for (int j = 0; j < 4; ++j) ebl[j] = __expf(blt[j]);
                if (fr == 0) { *(f32x4*)(s_bl + 16 * wid + 4 * fq) = blt; }
#pragma unroll
                for (int ti = 0; ti < 4; ++ti) {
                    const int i = 16 * ti + fr;
                    const int islot = 32 * (i >> 5) + 8 * ((i >> 2) & 3) + 4 * ((i >> 4) & 1) + (i & 3);
                    f32x4 bc = (f32x4){0.f, 0.f, 0.f, 0.f};
#pragma unroll
                    for (int ks = 0; ks < 2; ++ks) {
                        bf16x8 tri;
#pragma unroll
                        for (int e = 0; e < 8; ++e) { const int jpos = 32 * ks + 16 * (e >> 2) + 4 * fq + (e & 3); tri[e] = (jpos <= i) ? (short)0x3F80 : (short)0; }
                        bc = mfma16(laf[ks], tri, bc);
                    }
                    const int d0 = 16 * wid + 4 * fq;
                    const u32x2 qv = *(const u32x2*)(Qe + i * 136 + d0), kv = *(const u32x2*)(Ke + i * 136 + d0);
                    float qf[4] = {bf2f((bf16_t)(qv[0] & 0xffffu)), bf2f((bf16_t)(qv[0] >> 16)), bf2f((bf16_t)(qv[1] & 0xffffu)), bf2f((bf16_t)(qv[1] >> 16))};
                    float kf[4] = {bf2f((bf16_t)(kv[0] & 0xffffu)), bf2f((bf16_t)(kv[0] >> 16)), bf2f((bf16_t)(kv[1] & 0xffffu)), bf2f((bf16_t)(kv[1] >> 16))};
                    float qo[4], ko[4];
#pragma unroll
                    for (int j = 0; j < 4; ++j) {
                        const float E = __expf(bc[j]), R = __expf(-bc[j]);
                        qo[j] = qf[j] * 0.08838834764831845f * E; ko[j] = kf[j] * R;
                        KdT[(d0 + j) * 72 + islot] = f2bf(ko[j] * ebl[j]);
                    }
                    u32x2 qw, kw; qw[0] = pack2(qo[0], qo[1]); qw[1] = pack2(qo[2], qo[3]); kw[0] = pack2(ko[0], ko[1]); kw[1] = pack2(ko[2], ko[3]);
                    *(u32x2*)(Qe + i * 136 + d0) = qw; *(u32x2*)(Ke + i * 136 + d0) = kw;
                }
            }
            lds_barrier();
            const int tr = wid >> 1, tc0 = (wid & 1) * 2;
#pragma unroll
            for (int k2 = 0; k2 < 2; ++k2) {
                const int tc = tc0 + k2; const int t = tr * 16 + fr;
                f32x4 a = (f32x4){0.f, 0.f, 0.f, 0.f};
                if (tc <= tr) {
#pragma unroll
                    for (int ks = 0; ks < 4; ++ks) a = mfma16(ldfrag(Ke, 136, tc * 16 + fr, ks * 32 + 8 * fq), ldfrag(Qe, 136, t, ks * 32 + 8 * fq), a);
#pragma unroll
                    for (int j = 0; j < 4; ++j) { const int sp = tc * 16 + 4 * fq + j; if (sp > t) a[j] = 0.f; }
                }
                u32x2 o; o[0] = pack2(a[0], a[1]); o[1] = pack2(a[2], a[3]);
                *(u32x2*)(Am + t * 72 + 32 * (tc >> 1) + 8 * fq + 4 * (tc & 1)) = o;
            }
            lds_barrier();
            const bf16_t* Sc = St + cur * 64 * 136; bf16_t* Sn = St + (cur ^ 1) * 64 * 136;
            auto vfrag = [&](int et, int ks) -> bf16x8 {
                const bf16_t* base = VT + (32 * ks + 4 * fq + (fr >> 2)) * 72 + 16 * et + 4 * (fr & 3);
                const s16x4 lo = __builtin_amdgcn_ds_read_tr16_b64_v4i16((LAS s16x4*)(LAS unsigned char*)(unsigned char*)base);
                const s16x4 hi = __builtin_amdgcn_ds_read_tr16_b64_v4i16((LAS s16x4*)(LAS unsigned char*)(unsigned char*)(base + 16 * 72));
                return __builtin_shufflevector(lo, hi, 0, 1, 2, 3, 4, 5, 6, 7);
            };
            if (ci >= 4) {
#pragma unroll
                for (int k2 = 0; k2 < 2; ++k2) {
                    const int tc = tc0 + k2; const int t = tr * 16 + fr;
                    f32x4 a = (f32x4){0.f, 0.f, 0.f, 0.f};
#pragma unroll
                    for (int ks = 0; ks < 2; ++ks) a = mfma16(vfrag(tc, ks), ldfrag(Am, 72, t, ks * 32 + 8 * fq), a);
#pragma unroll
                    for (int ks = 0; ks < 4; ++ks) a = mfma16(ldfrag(Sc, 136, tc * 16 + fr, ks * 32 + 8 * fq), ldfrag(Qe, 136, t, ks * 32 + 8 * fq), a);
                    u32x2 o; o[0] = pack2(a[0], a[1]); o[1] = pack2(a[2], a[3]);
                    *(u32x2*)(OO + (size_t)pos_row(r0, t) * D + h * 256 + es * 64 + tc * 16 + 4 * fq) = o;
                }
            }
#pragma unroll
            for (int et = 0; et < 4; ++et) {
                f32x4 a = Sacc[et];
#pragma unroll
                for (int j = 0; j < 4; ++j) a[j] *= __expf(s_bl[wid * 16 + 4 * fq + j]);
#pragma unroll
                for (int ks = 0; ks < 2; ++ks) a = mfma16(ldfrag(KdT, 72, wid * 16 + fr, ks * 32 + 8 * fq), vfrag(et, ks), a);
                Sacc[et] = a;
                u32x2 o; o[0] = pack2(a[0], a[1]); o[1] = pack2(a[2], a[3]);
                *(u32x2*)(Sn + (et * 16 + fr) * 136 + wid * 16 + 4 * fq) = o;
            }
            cur ^= 1;
        };
        for (int ci = 0; ci < 68; ci += 2) { step(ci, qA, kA, lA, vA, qB, kB, lB, vB); step(ci + 1, qB, kB, lB, vB, qA, kA, lA, vA); }
    }
    lds_barrier();
}

DI void phase_m1(const Params& p) {
    const int tid = tid_op(); const int lane = tid & 63, gw = bid_op() * 8 + (tid >> 6), nw = gridDim.x * 8;
    const bf16_t* P = (const bf16_t*)(p.ws + WS_PH);
    const bf16_t* OF = (const bf16_t*)(p.ws + WS_SC); const bf16_t* OB = OF + (size_t)T * D;
    bf16_t* HB = (bf16_t*)(p.ws + WS_HB);
    for (int row = TCTX + gw; row < T; row += nw) {
        const int c0 = lane * 16;
        float v[16]; float ss = 0.f;
#pragma unroll
        for (int hlf = 0; hlf < 2; ++hlf) {
            const u32x4 a = *(const u32x4*)(OF + (size_t)row * D + c0 + hlf * 8), bb = *(const u32x4*)(OB + (size_t)row * D + c0 + hlf * 8);
#pragma unroll
            for (int j = 0; j < 4; ++j) {
                const float x0 = bf2f((bf16_t)(a[j] & 0xffffu)) + bf2f((bf16_t)(bb[j] & 0xffffu)), x1 = bf2f((bf16_t)(a[j] >> 16)) + bf2f((bf16_t)(bb[j] >> 16));
                v[hlf * 8 + 2 * j] = x0; v[hlf * 8 + 2 * j + 1] = x1; ss += x0 * x0 + x1 * x1;
            }
        }
        ss += __shfl_xor(ss, 1); ss += __shfl_xor(ss, 2); ss += __shfl_xor(ss, 4); ss += __shfl_xor(ss, 8);
        const float rstd = rsqrtf(ss * (1.f / 256.f) + EPS);
        const int gc = c0 & 255;
#pragma unroll
        for (int hlf = 0; hlf < 2; ++hlf) {
            const u32x4 rr = *(const u32x4*)(P + (size_t)row * PLD + 2048 + c0 + hlf * 8);
            u32x4 o;
#pragma unroll
            for (int j = 0; j < 4; ++j) {
                const float r0 = bf2f((bf16_t)(rr[j] & 0xffffu)), r1 = bf2f((bf16_t)(rr[j] >> 16));
                o[j] = pack2(v[hlf * 8 + 2 * j] * rstd * p.gla_norm_g[gc + hlf * 8 + 2 * j] * siluf(r0), v[hlf * 8 + 2 * j + 1] * rstd * p.gla_norm_g[gc + hlf * 8 + 2 * j + 1] * siluf(r1));
            }
            *(u32x4*)(HB + (size_t)row * D + c0 + hlf * 8) = o;
        }
    }
}

#define XB_TMO      128
#define XB_XCNT(j)  (256  + 64 * (j))
#define XB_XSUB(j)  (1280 + 64 * (j))
#define XB_XGEN(j)  (2304 + 64 * (j))
#define XB_TOP      3328
#define XB_TOPGEN   3392
#define XCD_BAR_WORDS 3456
#define XB_SPIN_CAP (1u << 18)
DI unsigned xb_ld(unsigned* p) { return __hip_atomic_load(p, __ATOMIC_RELAXED, __HIP_MEMORY_SCOPE_AGENT); }
DI unsigned xb_add(unsigned* p, unsigned v) { return __hip_atomic_fetch_add(p, v, __ATOMIC_RELAXED, __HIP_MEMORY_SCOPE_AGENT); }
DI unsigned xb_xcc_id() { return (unsigned)__builtin_amdgcn_s_getreg((3 << 11) | 20) & 0xFu; }
#define XB_SPIN(cond, bar) do { unsigned _sp = 0; while (cond) { __builtin_amdgcn_s_sleep(1); \
    if ((++_sp & 255u) == 0u) { if (xb_ld(&(bar)[XB_TMO])) break; if (_sp > XB_SPIN_CAP) { atomicAdd(&(bar)[XB_TMO], 1u); break; } } } } while (0)
struct XcdBarrier { unsigned* bar; unsigned x; volatile LAS unsigned* st; };
DI XcdBarrier xcd_barrier_post(unsigned* bar, volatile LAS unsigned* st) {
    XcdBarrier b; b.bar = bar; b.x = xb_xcc_id(); b.st = st;
    if (threadIdx.x == 0) (void)xb_add(&bar[XB_XCNT(b.x)], 1u);
    return b;
}
DI void xcd_barrier_complete(unsigned* bar, unsigned x, unsigned& nloc, unsigned& nx) {
    const unsigned G = gridDim.x * gridDim.y * gridDim.z;
    unsigned sum, cnt, mine, sp = 0u;
    for (;;) {
        sum = 0u; cnt = 0u; mine = 0u;
#pragma unroll
        for (unsigned j = 0; j < 16; ++j) { const unsigned c = xb_ld(&bar[XB_XCNT(j)]); sum += c; cnt += (c > 0u) ? 1u : 0u; mine = (j == x) ? c : mine; }
        if (sum == G) break;
        __builtin_amdgcn_s_sleep(1);
        if ((++sp & 255u) == 0u) { if (xb_ld(&bar[XB_TMO])) break; if (sp > XB_SPIN_CAP) { atomicAdd(&bar[XB_TMO], 1u); break; } }
    }
    nloc = mine > 0u ? mine : 1u; nx = cnt > 0u ? cnt : 1u;
}
DI void xcd_barrier(unsigned* bar_, unsigned char* smem_) {
    asm volatile("s_waitcnt vmcnt(0)" ::: "memory");
    __syncthreads();
    if (threadIdx.x == 0) {
        XcdBarrier b; b.bar = bar_; b.x = xb_xcc_id(); b.st = (volatile LAS unsigned*)(LAS unsigned char*)(smem_ + LDS_BYTES - 16);
        unsigned* bar = b.bar;
        __builtin_amdgcn_s_waitcnt(0);
        unsigned nloc = b.st[0], nx = b.st[1];
        if (nloc == 0u) { xcd_barrier_complete(bar, b.x, nloc, nx); b.st[0] = nloc; b.st[1] = nx; }
        const unsigned old = xb_add(&bar[XB_XSUB(b.x)], 1u);
        const unsigned gen = old / nloc;
        if (old + 1u == (gen + 1u) * nloc) {
            __builtin_amdgcn_fence(__ATOMIC_RELEASE, "agent");
            asm volatile("s_waitcnt vmcnt(0)" ::: "memory");
            const unsigned og = xb_add(&bar[XB_TOP], 1u);
            const unsigned tg = og / nx;
            if (og + 1u == (tg + 1u) * nx) xb_add(&bar[XB_TOPGEN], 1u);
            else XB_SPIN(xb_ld(&bar[XB_TOPGEN]) == tg, bar);
            __builtin_amdgcn_fence(__ATOMIC_ACQUIRE, "agent");
            xb_add(&bar[XB_XGEN(b.x)], 1u);
            asm volatile("s_waitcnt vmcnt(0)" ::: "memory");
        } else {
            XB_SPIN(xb_ld(&bar[XB_XGEN(b.x)]) == gen, bar);
            __builtin_amdgcn_fence(__ATOMIC_ACQUIRE, "agent");
            asm volatile("s_waitcnt vmcnt(0)" ::: "memory");
        }
    }
    __syncthreads();
}

constexpr int N_PHASES = 26;
#ifndef PH_MASK
#define PH_MASK 0xFFFFu
#endif
#define PH_ON(k) ((PH_MASK >> (k)) & 1u)
DI void run_phase(const Params& p, int ph, unsigned char* smem, int rep) {
    bf16_t* HB = (bf16_t*)(p.ws + WS_HB);
    bf16_t* PH = (bf16_t*)(p.ws + WS_PH);
    float* XC = (float*)(p.ws + WS_XC);
    if (ph == 0) { if (PH_ON(0)) phase_prep(p, smem); return; }
    if (ph == 25) { if (PH_ON(11)) phase_final(p.out, p.final_g); return; }
    const int l = (ph - 1) / 12, s = (ph - 1) % 12;
    const float* mods_l = (const float*)(p.ws + WS_MODS) + (size_t)l * 9 * NMOD;
    const bool first = (l == 0 && s <= 2);
    const float* src_ctx = first ? p.ctx : XC; const float* src_lat = first ? p.x : p.out;
    const int lat_only = (l == 1 && s >= 8) ? 1 : 0;
    const int row_lo = lat_only ? TCTX : 0;
    g8::StaticOrder S;
    LAS unsigned char* lds = (LAS unsigned char*)smem;
    switch (s) {
    case 0: case 3: case 9: if (PH_ON(1)) {
        const bool pend = (s == 3) || (s == 9 && l == 0) || (s == 0 && l == 1);
        const int nsl = s == 9 ? 4 : 8;
        phase_norm((s == 0 && l == 0) ? p.ctx : XC, (s == 0 && l == 0) ? p.x : p.out, HB, mods_l, p.norm_g + (size_t)(l * 3 + (s == 0 ? 0 : (s == 3 ? 1 : 2))) * D, s == 0 ? 0 : (s == 3 ? 3 : 6), s == 9 ? row_lo : 0,
                   pend ? (const bf16_t*)(p.ws + WS_SC) : nullptr, nsl, XC);
    } break;

    case 1: case 10: if (PH_ON(2)) {
        const int f = s == 1 ? 0 : 1;
        g8::Gemm g{HB + (size_t)row_lo * D, (const bf16_t*)(p.ws + WS_WFI + (size_t)(l * 2 + f) * SZ_WFI), T - row_lo, NFF, D, D};
        S.init(g.M, g.N, gridDim.x, bid_op());
        g8::EpiSwiglu E{PH, row_lo};
        g8::gemm_phase(lds, g, S, E);
    } break;
    case 2: case 11: case 8: if (PH_ON(3)) {
        const bf16_t* Ab; const bf16_t* Wb; int K; int gate_idx; float coef;
        if (s == 8) { Ab = HB; Wb = (const bf16_t*)(p.ws + WS_WMO + (size_t)l * SZ_WMO); K = D; gate_idx = 5; coef = 1.0f; }
        else { const int f = s == 2 ? 0 : 1; Ab = PH; Wb = (const bf16_t*)(p.ws + WS_WFO + (size_t)(l * 2 + f) * SZ_WFO); K = DFF; gate_idx = f == 0 ? 2 : 8; coef = 0.5f; }
        {
            g8::Gemm g{Ab + (size_t)TCTX * K, Wb, TLAT, D, K, K};
            g8::EpiResid E;
            E.src_ctx = src_ctx; E.src_lat = src_lat; E.dst_ctx = XC; E.dst_lat = p.out; E.mods = mods_l; E.row_base = TCTX; E.gate_idx = gate_idx; E.coef = coef;
            S.init(g.M, g.N, gridDim.x, bid_op());
            g8::gemm_phase(lds, g, S, E);
        }
        if (!lat_only) {
            const int nsl = K == D ? 4 : 8, nitems = 32 * nsl;
            for (int item = bid_op(); item < nitems; item += gridDim.x) {
                const int u = item / nsl, sl = item % nsl;
                int k0, kl;
                if (K == D) { k0 = sl * 256; kl = 256; } else if (sl < 6) { k0 = sl * 384; kl = 384; } else { k0 = 2304 + (sl - 6) * 256; kl = 256; }
                g8::Gemm g{Ab + k0, Wb + k0, TCTX, D, kl, K};
                g8::SingleUnit SU; SU.u.pm = u >> 2; SU.u.pn = u & 3;
                g8::EpiPartial E{(bf16_t*)(p.ws + WS_SC) + (size_t)sl * TCTX * D, mods_l + (size_t)8 * NMOD + gate_idx * D, coef};
                g8::gemm_phase(lds, g, SU, E);
            }
        }
    } break;
    case 4: if (PH_ON(4)) {
        g8::Gemm g{HB, (const bf16_t*)(p.ws + WS_WMI + (size_t)l * SZ_WMI), T, PN, D, D};
        S.init(g.M, g.N, gridDim.x, bid_op());
        g8::EpiP E{PH, l == 0 ? (float*)(p.ws + WS_GATES) : nullptr, p.gate_b};
        g8::gemm_phase(lds, g, S, E);
    } break;
    case 5: if (l == 0) { if (PH_ON(5)) phase_e0(p, smem); } else { if (PH_ON(6)) phase_e1(p, smem); } break;
    case 6: if (l == 0) { if (PH_ON(7)) phase_a0(p, smem, rep); } else { if (PH_ON(8)) phase_s1(p, smem); } break;
    case 7: if (l == 0) { if (PH_ON(9)) phase_m0(p); } else { if (PH_ON(10)) phase_m1(p); } break;
    }
}

__global__ void __launch_bounds__(NTHREADS, 2) fwd_kernel(Params p) {
    extern __shared__ __attribute__((aligned(16))) unsigned char smem[];
    if (p.coop) {
        volatile LAS unsigned* st = (volatile LAS unsigned*)(LAS unsigned char*)(smem + LDS_BYTES - 16);
        if (threadIdx.x == 0) { st[0] = 0u; st[1] = 0u; }
        __syncthreads();
        (void)xcd_barrier_post((unsigned*)(p.ws + WS_CTL), st);
    }
    for (int ph = p.ph_lo; ph < p.ph_hi; ++ph) {
        run_phase(p, ph, smem, 0);
#ifdef DUP_SYNC
        if (ph == 1) { for (int k = 0; k < 20; ++k) xcd_barrier((unsigned*)(p.ws + WS_CTL), smem); }
#endif
#ifdef DUP_PHASE
        if (ph == DUP_PHASE) { cg::this_grid().sync(); run_phase(p, ph, smem, 1); }
#endif
        if (p.coop && ph + 1 < p.ph_hi) {
            if (p.pad == 0x7fffffff) cg::this_grid().sync();
            xcd_barrier((unsigned*)(p.ws + WS_CTL), smem);
        }
    }
}

extern "C" void kernel_launch(void* const* d_in, const int* in_sizes, int n_in, void* d_out, int out_size, void* d_ws, size_t ws_size, hipStream_t stream) {
    static int grid = 0;
    if (grid == 0) {
        if (n_in != 23 || ws_size < WS_END) { fprintf(stderr, "kernel_launch: unexpected n_in %d or workspace %zu < %zu\n", n_in, ws_size, (size_t)WS_END); grid = -1; return; }
        int dev = 0, cus = 0, per_cu = 0;
        hipGetDevice(&dev);
        hipDeviceGetAttribute(&cus, hipDeviceAttributeMultiprocessorCount, dev);
        if (hipFuncSetAttribute((const void*)fwd_kernel, hipFuncAttributeMaxDynamicSharedMemorySize, LDS_BYTES) != hipSuccess) { fprintf(stderr, "kernel_launch: hipFuncSetAttribute failed\n"); grid = -1; return; }
        hipOccupancyMaxActiveBlocksPerMultiprocessor(&per_cu, (const void*)fwd_kernel, NTHREADS, LDS_BYTES);
        if (per_cu < 1) per_cu = 1;
        grid = cus * per_cu;
        (void)hipGetLastError();
    }
    if (grid < 0) return;
    (void)hipMemsetAsync((char*)d_ws + WS_CTL, 0, 16384, stream);
    Params p{};
    const float** pp = (const float**)&p;
    for (int i = 0; i < 23; ++i) pp[i] = (const float*)d_in[i];
    p.out = (float*)d_out; p.ws = (unsigned char*)d_ws;
#if ONE_LAUNCH
    p.ph_lo = 0; p.ph_hi = N_PHASES; p.coop = 1;
    void* args[] = {&p};
    hipError_t e = hipLaunchCooperativeKernel((const void*)fwd_kernel, dim3(grid), dim3(NTHREADS), args, LDS_BYTES, stream);
    if (e != hipSuccess) fprintf(stderr, "cooperative launch failed: %s (grid %d)\n", hipGetErrorString(e), grid);
#else
    for (int ph = 0; ph < N_PHASES; ++ph) {
        p.ph_lo = ph; p.ph_hi = ph + 1; p.coop = 0;
        hipLaunchKernelGGL(fwd_kernel, dim3(grid), dim3(NTHREADS), LDS_BYTES, stream, p);
    }
#endif
}
```

```cpp
#include <hip/hip_runtime.h>
#include <hip/hip_cooperative_groups.h>
#include <cstdio>
#include <type_traits>
namespace cg = cooperative_groups;

#ifndef ONE_LAUNCH
#define ONE_LAUNCH 1
#endif

#define DI __device__ __forceinline__
#define LAS __attribute__((address_space(3)))
typedef unsigned short bf16_t;
typedef short bf16x8 __attribute__((ext_vector_type(8)));
typedef short s16x4 __attribute__((ext_vector_type(4)));
typedef float f32x4 __attribute__((ext_vector_type(4)));
typedef unsigned u32x4 __attribute__((ext_vector_type(4)));
typedef unsigned u32x2 __attribute__((ext_vector_type(2)));

constexpr int D = 1024, NB = 8, SEQ = 4096, CTXL = 256;
constexpr int TCTX = NB * CTXL;
constexpr int TLAT = NB * SEQ;
constexpr int T = TCTX + TLAT;
constexpr int DFF = 2816, NFF = 5632;
constexpr int PN = 3328;
constexpr int PLD = 3104;
constexpr int NMOD = 9 * D;
constexpr float EPS = 1e-6f;
constexpr int NTHREADS = 512;
constexpr int LDS_BYTES = 147456;

constexpr size_t WS_CTL = 0;
constexpr size_t WS_MODS = 16384;
constexpr size_t WS_GATES = WS_MODS + (size_t)2 * 9 * NMOD * 4;
constexpr size_t WS_XC = WS_GATES + (size_t)T * 16 * 4;
constexpr size_t WS_WFI = WS_XC + (size_t)TCTX * D * 4;
constexpr size_t SZ_WFI = (size_t)NFF * D * 2;
constexpr size_t WS_WFO = WS_WFI + 4 * SZ_WFI;
constexpr size_t SZ_WFO = (size_t)D * DFF * 2;
constexpr size_t WS_WMI = WS_WFO + 4 * SZ_WFO;
constexpr size_t SZ_WMI = (size_t)PN * D * 2;
constexpr size_t WS_WMO = WS_WMI + 2 * SZ_WMI;
constexpr size_t SZ_WMO = (size_t)D * D * 2;
constexpr size_t WS_HB = WS_WMO + 2 * SZ_WMO;
constexpr size_t WS_PH = WS_HB + (size_t)T * D * 2;
constexpr size_t WS_SC = WS_PH + (size_t)T * PLD * 2;
constexpr size_t WS_END = WS_SC + (size_t)T * D * 2 * 2;

struct Params {
    const float *x, *c, *ctx, *c_ctx, *ada_w, *ada_b, *norm_g, *ffn_w_in, *ffn_w_out, *even_w_in, *even_w_out, *diff_lambda, *diff_norm_g,
        *conv_w, *conv_b, *gate_b, *ml_norm_g, *odd_w_in, *odd_w_out, *gla_w_gate, *gla_b_gate, *gla_norm_g, *final_g;
    float* out;
    unsigned char* ws;
    int ph_lo, ph_hi, coop, pad;
};

DI int tid_op() { int t = threadIdx.x; asm volatile("" : "+v"(t)); return t; }
DI int bid_op() { int b = blockIdx.x; asm volatile("" : "+s"(b)); return b; }
DI bf16_t f2bf(float f) { unsigned u = __float_as_uint(f); u += 0x7fffu + ((u >> 16) & 1u); return (bf16_t)(u >> 16); }
DI float bf2f(bf16_t b) { return __uint_as_float(((unsigned)b) << 16); }
typedef __bf16 hbf2 __attribute__((ext_vector_type(2)));
typedef float f32x2 __attribute__((ext_vector_type(2)));
DI unsigned pack2(float lo, float hi) { const f32x2 v = {lo, hi}; const hbf2 r = __builtin_convertvector(v, hbf2); return __builtin_bit_cast(unsigned, r); }
DI float siluf(float a) { return a * __builtin_amdgcn_rcpf(1.f + __expf(-a)); }
DI float sigmoidf(float a) { return __builtin_amdgcn_rcpf(1.f + __expf(-a)); }
DI float logsigf(float x) { return fminf(x, 0.f) - __logf(1.f + __expf(-fabsf(x))); }
DI void lds_barrier() { asm volatile("s_waitcnt lgkmcnt(0)" ::: "memory"); __builtin_amdgcn_s_barrier(); asm volatile("" ::: "memory"); }
DI f32x4 mfma16(bf16x8 a, bf16x8 b, f32x4 c) { return __builtin_amdgcn_mfma_f32_16x16x32_bf16(a, b, c, 0, 0, 0); }
DI bf16x8 ldfrag(const bf16_t* base, int ld, int row, int k0) { return *(const bf16x8*)(base + row * ld + k0); }
DI float wave_sum(float v) { for (int o = 32; o > 0; o >>= 1) v += __shfl_xor(v, o); return v; }
DI float wave_max(float v) { for (int o = 32; o > 0; o >>= 1) v = fmaxf(v, __shfl_xor(v, o)); return v; }
DI const float* xrow_src(const float* sc, const float* sl, int row) { return row < TCTX ? sc + (size_t)row * D : sl + (size_t)(row - TCTX) * D; }
DI float* xrow_dst(float* sc, float* sl, int row) { return row < TCTX ? sc + (size_t)row * D : sl + (size_t)(row - TCTX) * D; }
DI int mod_row(int row) { return row < TCTX ? 8 : (row - TCTX) >> 12; }

namespace g8 {
constexpr int BM = 256, BK = 64, HALF = 128, HTB = HALF * BK * 2, NXCD = 8, WGM = 8;
DI int lds_byte(int r, int c) { const int st = (r >> 4) * 2 + (c >> 5), rr = r & 15, cc = c & 31, ob = rr * 64 + cc * 2; return st * 1024 + (ob ^ (((ob >> 9) & 1) << 5)); }
DI void stage_rc(int b, int& R, int& C) { const int st = b / 1024, sb = b % 1024, swz = sb ^ (((sb >> 9) & 1) << 5); R = (st >> 1) * 16 + swz / 64; C = (st & 1) * 32 + (swz % 64) / 2; }
DI int perm32(int rho) { const int n = rho >> 4, i = rho & 15; return 8 * (i >> 2) + 4 * n + (i & 3); }
struct Unit { int pm, pn; };
struct Gemm { const bf16_t* A; const bf16_t* Bt; int M, N, K, ld; };
struct SingleUnit { Unit u; DI bool next(int i, Unit& o) const { if (i != 0) return false; o = u; return true; } };
struct StaticOrder {
    int nM, nN, nwg, G, c;
    DI void init(int M, int N, int G_, int c_) { nM = M / BM; nN = N / BM; nwg = nM * nN; G = G_; c = c_; }
    DI bool next(int i, Unit& u) const {
        const long L = (long)i * G + c; if (L >= nwg) return false;
        int wgid = (int)L; { const int q = nwg / NXCD, r = nwg % NXCD, xcd = wgid % NXCD, off = wgid / NXCD; wgid = (xcd < r ? xcd * (q + 1) : r * (q + 1) + (xcd - r) * q) + off; }
        const int nig = WGM * nN, gid = wgid / nig, fm = gid * WGM, gsz = (nM - fm) < WGM ? (nM - fm) : WGM;
        u.pm = fm + ((wgid % nig) % gsz); u.pn = (wgid % nig) / gsz; return true;
    }
};

template <class Epi, class Sched>
DI void gemm_phase(LAS unsigned char* lds, const Gemm g, const Sched& S, const Epi& E) {
    const int tid = tid_op(), wid = __builtin_amdgcn_readfirstlane(tid >> 6), lane = tid & 63, wr = wid >> 2, wc = wid & 3, fr = lane & 15, fq = lane >> 4;
    const int K = g.K, nt = K / BK, LD = g.ld;
    unsigned voffA[2], voffB[2];
#pragma unroll
    for (int i = 0; i < 2; ++i) { int R, C; stage_rc(tid * 16 + i * 8192, R, C); const int Rb = Epi::PERM ? ((R & ~31) + perm32(R & 31)) : R;
        voffA[i] = (unsigned)(R * LD + C) * 2u; voffB[i] = (unsigned)(Rb * LD + C) * 2u; }
    const size_t kstep = (size_t)(BK * 2);
    const size_t hstep = (size_t)HALF * LD * 2;
    const size_t tstep = 2 * hstep;
    const unsigned ldsw = (unsigned)wid * 1024u;
    const int aoff = lds_byte(wr * 64 + fr, fq * 8), boff = lds_byte(wc * 32 + fr, fq * 8);
#define G8_SA(b, h) (((b) * 2 + (h)) * HTB)
#define G8_SB(b, h) ((4 + (b) * 2 + (h)) * HTB)
#define G8_STAGE(bufoff, gbase, voff) do { _Pragma("unroll") for (int _i = 0; _i < 2; ++_i) \
        __builtin_amdgcn_global_load_lds((const unsigned*)((const char*)(gbase) + (voff)[_i]), (LAS unsigned*)(lds + (bufoff) + ldsw + _i * 8192), 16, 0, 0); } while (0)
#define G8_LDA(dst, b, h) do { _Pragma("unroll") for (int m = 0; m < 4; ++m) _Pragma("unroll") for (int k = 0; k < 2; ++k) dst[m][k] = *(const LAS bf16x8*)(lds + G8_SA(b, h) + aoff + m * 2048 + k * 1024); } while (0)
#define G8_LDB(dst, b, h) do { _Pragma("unroll") for (int n = 0; n < 2; ++n) _Pragma("unroll") for (int k = 0; k < 2; ++k) dst[n][k] = *(const LAS bf16x8*)(lds + G8_SB(b, h) + boff + n * 2048 + k * 1024); } while (0)
#define G8_MMA(ai, bj, At, Bt) do { __builtin_amdgcn_s_setprio(1); _Pragma("unroll") for (int m = 0; m < 4; ++m) _Pragma("unroll") for (int n = 0; n < 2; ++n) _Pragma("unroll") for (int k = 0; k < 2; ++k) \
        acc[ai][bj][m][n] = __builtin_amdgcn_mfma_f32_16x16x32_bf16(Bt[n][k], At[m][k], acc[ai][bj][m][n], 0, 0, 0); __builtin_amdgcn_s_setprio(0); } while (0)
#define G8_WAIT_V(n) asm volatile("s_waitcnt vmcnt(" #n ")" ::: "memory")
#define G8_WAIT_L(n) asm volatile("s_waitcnt lgkmcnt(" #n ")" ::: "memory")
#define G8_BAR __builtin_amdgcn_s_barrier()
#define G8_SCHED __builtin_amdgcn_sched_barrier(0)
    Unit cur, nxt; int ui = 0;
    if (!S.next(0, cur)) return;
    f32x4 acc[2][2][4][2];
#pragma unroll
    for (int a = 0; a < 2; ++a)
#pragma unroll
        for (int b = 0; b < 2; ++b)
#pragma unroll
            for (int m = 0; m < 4; ++m)
#pragma unroll
                for (int n = 0; n < 2; ++n) acc[a][b][m][n] = (f32x4){0.f, 0.f, 0.f, 0.f};
    bf16x8 At[4][2], B0[2][2], B1[2][2];
    const char* cA = (const char*)g.A + (size_t)cur.pm * tstep; const char* cB = (const char*)g.Bt + (size_t)cur.pn * tstep;
    G8_STAGE(G8_SB(0, 0), cB, voffB); G8_STAGE(G8_SA(0, 0), cA, voffA); G8_STAGE(G8_SB(0, 1), cB + hstep, voffB); G8_STAGE(G8_SA(0, 1), cA + hstep, voffA);
    if (wr == 1) G8_BAR;
    G8_WAIT_V(4); G8_BAR;
    G8_STAGE(G8_SB(1, 0), cB + kstep, voffB); G8_STAGE(G8_SA(1, 0), cA + kstep, voffA); G8_STAGE(G8_SB(1, 1), cB + hstep + kstep, voffB);
    G8_WAIT_V(6); G8_BAR;
    for (;;) {
        const bool has_next = S.next(ui + 1, nxt);
        const char* nA = has_next ? (const char*)g.A + (size_t)nxt.pm * tstep : cA; const char* nB = has_next ? (const char*)g.Bt + (size_t)nxt.pn * tstep : cB;
        for (int t = 0; t < nt; t += 2) {
            const bool last = (t == nt - 2);
            const char* a1 = cA + (size_t)(t + 1) * kstep;
            const char* a2 = last ? nA : cA + (size_t)(t + 2) * kstep; const char* b2 = last ? nB : cB + (size_t)(t + 2) * kstep;
            const char* a3 = a2 + kstep; const char* b3 = b2 + kstep;
            G8_LDB(B0, 0, 0); G8_SCHED; G8_LDA(At, 0, 0); G8_STAGE(G8_SA(1, 1), a1 + hstep, voffA);
            G8_WAIT_L(8); G8_BAR; G8_WAIT_L(0); G8_MMA(0, 0, At, B0); G8_BAR; G8_SCHED;
            G8_LDB(B1, 0, 1); G8_STAGE(G8_SB(0, 0), b2, voffB);
            G8_BAR; G8_WAIT_L(0); G8_MMA(0, 1, At, B1); G8_BAR;
            G8_LDA(At, 0, 1); G8_STAGE(G8_SA(0, 0), a2, voffA);
            G8_BAR; G8_WAIT_L(0); G8_MMA(1, 0, At, B0); G8_BAR; G8_SCHED;
            G8_STAGE(G8_SB(0, 1), b2 + hstep, voffB);
            G8_WAIT_V(6); G8_BAR; G8_MMA(1, 1, At, B1); G8_BAR;
            G8_LDB(B0, 1, 0); G8_SCHED; G8_LDA(At, 1, 0); G8_STAGE(G8_SA(0, 1), a2 + hstep, voffA);
            G8_WAIT_L(8); G8_BAR; G8_WAIT_L(0); G8_MMA(0, 0, At, B0); G8_BAR; G8_SCHED;
            G8_LDB(B1, 1, 1); G8_STAGE(G8_SB(1, 0), b3, voffB);
            G8_BAR; G8_WAIT_L(0); G8_MMA(0, 1, At, B1); G8_BAR;
            G8_LDA(At, 1, 1); G8_STAGE(G8_SA(1, 0), a3, voffA);
            G8_BAR; G8_WAIT_L(0); G8_MMA(1, 0, At, B0); G8_BAR; G8_SCHED;
            G8_STAGE(G8_SB(1, 1), b3 + hstep, voffB);
            G8_WAIT_V(6); G8_BAR; G8_MMA(1, 1, At, B1); G8_BAR;
        }
        E(acc, cur, wr, wc, fr, fq);
        if (!has_next) break;
#pragma unroll
        for (int a = 0; a < 2; ++a)
#pragma unroll
            for (int b = 0; b < 2; ++b)
#pragma unroll
                for (int m = 0; m < 4; ++m)
#pragma unroll
                    for (int n = 0; n < 2; ++n) acc[a][b][m][n] = (f32x4){0.f, 0.f, 0.f, 0.f};
        cur = nxt; cA = nA; cB = nB; ++ui;
    }
    G8_WAIT_V(0);
    if (wr == 0) G8_BAR;
    G8_BAR;
#undef G8_SA
#undef G8_SB
#undef G8_STAGE
#undef G8_LDA
#undef G8_LDB
#undef G8_MMA
#undef G8_WAIT_V
#undef G8_WAIT_L
#undef G8_BAR
#undef G8_SCHED
}

struct EpiSwiglu {
    static constexpr bool PERM = true;
    bf16_t* H; int row_base;
    DI void operator()(const f32x4 (&acc)[2][2][4][2], const Unit& u, int wr, int wc, int fr, int fq) const {
        const int row0 = row_base + u.pm * BM + wr * 64 + fr, col0 = u.pn * 128 + wc * 32 + 8 * fq;
#pragma unroll
        for (int ai = 0; ai < 2; ++ai)
#pragma unroll
            for (int m = 0; m < 4; ++m) {
                bf16_t* rowp = H + (size_t)(row0 + ai * HALF + m * 16) * DFF + col0;
                const f32x4 a0 = acc[ai][0][m][0], a1 = acc[ai][0][m][1], b0 = acc[ai][1][m][0], b1 = acc[ai][1][m][1];
                u32x4 o;
                o[0] = pack2(siluf(a0[0]) * b0[0], siluf(a0[1]) * b0[1]); o[1] = pack2(siluf(a0[2]) * b0[2], siluf(a0[3]) * b0[3]);
                o[2] = pack2(siluf(a1[0]) * b1[0], siluf(a1[1]) * b1[1]); o[3] = pack2(siluf(a1[2]) * b1[2], siluf(a1[3]) * b1[3]);
                *(u32x4*)rowp = o;
            }
    }
};
struct EpiResid {
    static constexpr bool PERM = false;
    const float* src_ctx; const float* src_lat; float* dst_ctx; float* dst_lat; const float* mods; int gate_idx; float coef; int row_base;
    DI void operator()(const f32x4 (&acc)[2][2][4][2], const Unit& u, int wr, int wc, int fr, int fq) const {
        const int trow = row_base + u.pm * BM;
        const float* gate = mods + (size_t)mod_row(trow) * NMOD + gate_idx * D;
        const float* Sp = xrow_src(src_ctx, src_lat, trow); float* Dp = xrow_dst(dst_ctx, dst_lat, trow);
        const int r0 = wr * 64 + fr, col0 = u.pn * BM + wc * 32 + 4 * fq;
        auto& A = const_cast<f32x4 (&)[2][2][4][2]>(acc);
        {
            f32x4 gv[2][2];
            __builtin_amdgcn_sched_barrier(0);
#pragma unroll
            for (int bj = 0; bj < 2; ++bj)
#pragma unroll
                for (int n = 0; n < 2; ++n) gv[bj][n] = *(const f32x4*)(gate + col0 + bj * HALF + n * 16);
            __builtin_amdgcn_sched_barrier(0);
#pragma unroll
            for (int bj = 0; bj < 2; ++bj)
#pragma unroll
                for (int n = 0; n < 2; ++n) {
                    const f32x4 gvv = gv[bj][n] * coef;
#pragma unroll
                    for (int ai = 0; ai < 2; ++ai)
#pragma unroll
                        for (int m = 0; m < 4; ++m) { A[ai][bj][m][n] *= gvv; asm volatile("" : "+v"(A[ai][bj][m][n])); }
                }
        }
        auto batch = [&](auto MM, int ai, int m0) {
            constexpr int NM = decltype(MM)::value;
            f32x4 xv[NM][2][2];
            __builtin_amdgcn_sched_barrier(0);
#pragma unroll
            for (int mm = 0; mm < NM; ++mm)
#pragma unroll
                for (int bj = 0; bj < 2; ++bj)
#pragma unroll
                    for (int n = 0; n < 2; ++n) xv[mm][bj][n] = *(const f32x4*)(Sp + (size_t)(r0 + ai * HALF + (m0 + mm) * 16) * D + col0 + bj * HALF + n * 16);
            __builtin_amdgcn_sched_barrier(0);
            asm volatile("s_waitcnt vmcnt(0)" ::: "memory");
            __builtin_amdgcn_sched_barrier(0);
#pragma unroll
            for (int mm = 0; mm < NM; ++mm)
#pragma unroll
                for (int bj = 0; bj < 2; ++bj)
#pragma unroll
                    for (int n = 0; n < 2; ++n) *(f32x4*)(Dp + (size_t)(r0 + ai * HALF + (m0 + mm) * 16) * D + col0 + bj * HALF + n * 16) = xv[mm][bj][n] + A[ai][bj][m0 + mm][n];
            asm volatile("" ::: "memory");
        };
        __builtin_amdgcn_sched_barrier(0);
        batch(std::integral_constant<int, 2>{}, 0, 0); batch(std::integral_constant<int, 2>{}, 0, 2);
        batch(std::integral_constant<int, 2>{}, 1, 0); batch(std::integral_constant<int, 2>{}, 1, 2);
    }
};
struct EpiPartial {
    static constexpr bool PERM = false;
    bf16_t* slab; const float* gate; float coef;
    DI void operator()(const f32x4 (&acc)[2][2][4][2], const Unit& u, int wr, int wc, int fr, int fq) const {
        const int r0 = u.pm * BM + wr * 64 + fr, col0 = u.pn * BM + wc * 32 + 4 * fq;
#pragma unroll
        for (int bj = 0; bj < 2; ++bj)
#pragma unroll
            for (int n = 0; n < 2; ++n) {
                const f32x4 gv = *(const f32x4*)(gate + col0 + bj * HALF + n * 16) * coef;
#pragma unroll
                for (int ai = 0; ai < 2; ++ai)
#pragma unroll
                    for (int m = 0; m < 4; ++m) {
                        const f32x4 v = gv * acc[ai][bj][m][n];
                        u32x2 o; o[0] = pack2(v[0], v[1]); o[1] = pack2(v[2], v[3]);
                        *(u32x2*)(slab + (size_t)(r0 + ai * HALF + m * 16) * D + col0 + bj * HALF + n * 16) = o;
                    }
            }
    }
};
struct EpiP {
    static constexpr bool PERM = true;
    bf16_t* P; float* gates; const float* gate_b;
    DI void operator()(const f32x4 (&acc)[2][2][4][2], const Unit& u, int wr, int wc, int fr, int fq) const {
        const int row0 = u.pm * BM + wr * 64 + fr;
#pragma unroll
        for (int bj = 0; bj < 2; ++bj) {
            const int col0 = u.pn * BM + bj * HALF + wc * 32 + 8 * fq;
            if (col0 >= PLD) continue;
            const bool isg = gates != nullptr && col0 >= 3072 && col0 < 3088;
#pragma unroll
            for (int ai = 0; ai < 2; ++ai)
#pragma unroll
                for (int m = 0; m < 4; ++m) {
                    const int row = row0 + ai * HALF + m * 16;
                    const f32x4 v0 = acc[ai][bj][m][0], v1 = acc[ai][bj][m][1];
                    u32x4 o; o[0] = pack2(v0[0], v0[1]); o[1] = pack2(v0[2], v0[3]); o[2] = pack2(v1[0], v1[1]); o[3] = pack2(v1[2], v1[3]);
                    *(u32x4*)(P + (size_t)row * PLD + col0) = o;
                    if (isg) {
                        const int gc = col0 - 3072;
                        float* gp = gates + (size_t)row * 16 + gc;
                        const f32x4 b0 = *(const f32x4*)(gate_b + gc), b1 = *(const f32x4*)(gate_b + gc + 4);
                        *(f32x4*)gp = v0 + b0; *(f32x4*)(gp + 4) = v1 + b1;
                    }
                }
        }
    }
};
}

struct TrJob { const float* src; bf16_t* dst; int K, Nsrc, Nvalid, mode, tk, tn; };
DI void tr_load(const TrJob& j, f32x4 (&r)[8]) {
    const int tid = tid_op(), n = j.tn * 256 + (tid & 63) * 4, k0 = j.tk * 64;
    const int sc = j.mode == 1 ? ((n >> 7) & 1) * DFF + (n >> 8) * 128 + (n & 127) : n;
#pragma unroll
    for (int it = 0; it < 8; ++it) { const int kk = it * 8 + (tid >> 6); r[it] = (n < j.Nvalid) ? *(const f32x4*)(j.src + (size_t)(k0 + kk) * j.Nsrc + sc) : (f32x4){0.f, 0.f, 0.f, 0.f}; }
}
DI void tr_store(const TrJob& j, const f32x4 (&r)[8], float* tile) {
    const int tid = tid_op(), n0 = j.tn * 256, k0 = j.tk * 64;
#pragma unroll
    for (int it = 0; it < 8; ++it) {
        float* tp = tile + (it * 8 + (tid >> 6)) * 257 + (tid & 63) * 4;
        tp[0] = r[it][0]; tp[1] = r[it][1]; tp[2] = r[it][2]; tp[3] = r[it][3];
    }
    __syncthreads();
    {
        const int g = tid & 7;
#pragma unroll
        for (int it = 0; it < 4; ++it) {
            const int rr = it * 64 + (tid >> 3);
            const float* tp = tile + (8 * g) * 257 + rr;
            u32x4 o;
            o[0] = pack2(tp[0], tp[257]); o[1] = pack2(tp[2 * 257], tp[3 * 257]); o[2] = pack2(tp[4 * 257], tp[5 * 257]); o[3] = pack2(tp[6 * 257], tp[7 * 257]);
            *(u32x4*)(j.dst + (size_t)(n0 + rr) * j.K + k0 + 8 * g) = o;
        }
    }
    __syncthreads();
}

DI void phase_prep(const Params& p, unsigned char* smem) {
    const int tid = tid_op(), bid = bid_op(), nblk = gridDim.x;
    { const f32x4* src = (const f32x4*)p.ctx; f32x4* dst = (f32x4*)(p.ws + WS_XC);
      for (int i = bid * NTHREADS + tid; i < TCTX * D / 4; i += nblk * NTHREADS) dst[i] = src[i]; }
    float* tile = (float*)smem;
    constexpr int N_FI = 16 * 22, N_FO = 44 * 4, N_MI = 16 * 13, N_MO = 16 * 4;
    constexpr int E_FI = 4 * N_FI, E_FO = E_FI + 4 * N_FO, E_MI = E_FO + 2 * N_MI, E_MO = E_MI + 2 * N_MO;
    auto decode = [&](int it) -> TrJob {
        TrJob j;
        if (it < E_FI) { const int q = it / N_FI, t = it % N_FI; j = TrJob{p.ffn_w_in + (size_t)q * D * NFF, (bf16_t*)(p.ws + WS_WFI + q * SZ_WFI), D, NFF, NFF, 1, t % 16, t / 16}; }
        else if (it < E_FO) { const int i2 = it - E_FI, q = i2 / N_FO, t = i2 % N_FO; j = TrJob{p.ffn_w_out + (size_t)q * DFF * D, (bf16_t*)(p.ws + WS_WFO + q * SZ_WFO), DFF, D, D, 0, t % 44, t / 44}; }
        else if (it < E_MI) { const int i2 = it - E_FO, q = i2 / N_MI, t = i2 % N_MI; j = TrJob{q == 0 ? p.even_w_in : p.odd_w_in, (bf16_t*)(p.ws + WS_WMI + q * SZ_WMI), D, q == 0 ? 3088 : 3104, q == 0 ? 3088 : 3104, 0, t % 16, t / 16}; }
        else { const int i2 = it - E_MI, q = i2 / N_MO, t = i2 % N_MO; j = TrJob{q == 0 ? p.even_w_out : p.odd_w_out, (bf16_t*)(p.ws + WS_WMO + q * SZ_WMO), D, D, D, 0, t % 16, t / 16}; }
        return j;
    };
    {
        f32x4 r0[8], r1[8], r2[8];
        int it = bid;
        if (it < E_MO) { TrJob j = decode(it); tr_load(j, r0); }
        if (it + nblk < E_MO) { TrJob j = decode(it + nblk); tr_load(j, r1); }
        for (;;) {
            if (it >= E_MO) break;
            if (it + 2 * nblk < E_MO) { TrJob jn = decode(it + 2 * nblk); tr_load(jn, r2); }
            { TrJob j = decode(it); tr_store(j, r0, tile); } it += nblk;
            if (it >= E_MO) break;
            if (it + 2 * nblk < E_MO) { TrJob jn = decode(it + 2 * nblk); tr_load(jn, r0); }
            { TrJob j = decode(it); tr_store(j, r1, tile); } it += nblk;
            if (it >= E_MO) break;
            if (it + 2 * nblk < E_MO) { TrJob jn = decode(it + 2 * nblk); tr_load(jn, r1); }
            { TrJob j = decode(it); tr_store(j, r2, tile); } it += nblk;
        }
    }
    float* sv = (float*)smem;
    f32x4* red = (f32x4*)(smem + 9 * D * 4);
    bool staged = false;
    for (int ch = bid; ch < 256; ch += nblk) {
        if (!staged) {
            __syncthreads();
            for (int i = tid; i < 9 * D; i += NTHREADS) { const float v = i < 8 * D ? p.c[i] : p.c_ctx[i - 8 * D]; sv[i] = siluf(v); }
            __syncthreads(); staged = true;
        }
        const int l = ch >> 7, j0 = (ch & 127) * 72, cg = tid % 18, kg = tid / 18;
        if (kg < 28) {
            f32x4 a[9];
#pragma unroll
            for (int r = 0; r < 9; ++r) a[r] = (f32x4){0.f, 0.f, 0.f, 0.f};
            const float* w = p.ada_w + (size_t)l * D * NMOD + j0 + 4 * cg;
            const int k1 = (kg + 1) * 37 < D ? (kg + 1) * 37 : D;
#pragma unroll 4
            for (int k = kg * 37; k < k1; ++k) {
                const f32x4 wv = *(const f32x4*)(w + (size_t)k * NMOD);
#pragma unroll
                for (int r = 0; r < 9; ++r) a[r] += wv * sv[r * D + k];
            }
#pragma unroll
            for (int r = 0; r < 9; ++r) red[(kg * 9 + r) * 18 + cg] = a[r];
        }
        __syncthreads();
        if (tid < 162) {
            const int r = tid / 18, cc = tid % 18; f32x4 sacc = (f32x4){0.f, 0.f, 0.f, 0.f};
            for (int g = 0; g < 28; ++g) sacc += red[(g * 9 + r) * 18 + cc];
            *(f32x4*)((float*)(p.ws + WS_MODS) + ((size_t)l * 9 + r) * NMOD + j0 + 4 * cc) = sacc + *(const f32x4*)(p.ada_b + (size_t)l * NMOD + j0 + 4 * cc);
        }
        __syncthreads();
    }
}

DI void phase_norm(const float* src_ctx, const float* src_lat, bf16_t* HB, const float* mods_l, const float* g, int kshift, int row_lo, const bf16_t* slab, int nsl, float* xc_out) {
    const int tid = tid_op(); const int lane = tid & 63, gw = bid_op() * 8 + (tid >> 6), nw = gridDim.x * 8;
    for (int row = row_lo + gw; row < T; row += nw) {
        const float* xr = xrow_src(src_ctx, src_lat, row);
        const float* md = mods_l + (size_t)mod_row(row) * NMOD;
        f32x4 v[4]; float ss = 0.f;
#pragma unroll
        for (int i = 0; i < 4; ++i) {
            v[i] = *(const f32x4*)(xr + i * 256 + lane * 4);
            if (slab != nullptr && row < TCTX) {
                for (int sl = 0; sl < nsl; ++sl) { const u32x2 q = *(const u32x2*)(slab + ((size_t)sl * TCTX + row) * D + i * 256 + lane * 4);
                    v[i][0] += bf2f((bf16_t)(q[0] & 0xffffu)); v[i][1] += bf2f((bf16_t)(q[0] >> 16)); v[i][2] += bf2f((bf16_t)(q[1] & 0xffffu)); v[i][3] += bf2f((bf16_t)(q[1] >> 16)); }
                *(f32x4*)(xc_out + (size_t)row * D + i * 256 + lane * 4) = v[i];
            }
            ss += v[i][0] * v[i][0] + v[i][1] * v[i][1] + v[i][2] * v[i][2] + v[i][3] * v[i][3];
        }
        ss = wave_sum(ss);
        const float rstd = rsqrtf(ss * (1.f / D) + EPS);
#pragma unroll
        for (int i = 0; i < 4; ++i) {
            const int cidx = i * 256 + lane * 4;
            const f32x4 gg = *(const f32x4*)(g + cidx), sh = *(const f32x4*)(md + kshift * D + cidx), sc = *(const f32x4*)(md + (kshift + 1) * D + cidx);
            const f32x4 h = v[i] * rstd * gg * (sc + 1.f) + sh;
            u32x2 o; o[0] = pack2(h[0], h[1]); o[1] = pack2(h[2], h[3]);
            *(u32x2*)(HB + (size_t)row * D + cidx) = o;
        }
    }
}

DI void phase_final(float* X, const float* g) {
    const int tid = tid_op(); const int lane = tid & 63, gw = bid_op() * 8 + (tid >> 6), nw = gridDim.x * 8;
    for (int row = gw; row < TLAT; row += nw) {
        float* xr = X + (size_t)row * D;
        f32x4 v[4]; float ss = 0.f;
#pragma unroll
        for (int i = 0; i < 4; ++i) { v[i] = *(const f32x4*)(xr + i * 256 + lane * 4); ss += v[i][0] * v[i][0] + v[i][1] * v[i][1] + v[i][2] * v[i][2] + v[i][3] * v[i][3]; }
        ss = wave_sum(ss);
        const float rstd = rsqrtf(ss * (1.f / D) + EPS);
#pragma unroll
        for (int i = 0; i < 4; ++i) { const int cidx = i * 256 + lane * 4; *(f32x4*)(xr + cidx) = v[i] * rstd * *(const f32x4*)(g + cidx); }
    }
}

DI void phase_e0(const Params& p, unsigned char* smem) {
    const int tid = tid_op();
    bf16_t* P = (bf16_t*)(p.ws + WS_PH);
    bf16_t* QKC = (bf16_t*)(p.ws + WS_SC);
    float* tab = (float*)smem;
    for (int i = tid; i < 1024; i += NTHREADS) {
        const int pos = i >> 4, f = i & 15;
        const float inv = powf(10000.0f, -(float)f * (2.0f / 32.0f));
        const float ang = (float)pos * inv;
        float s, c; sincosf(ang, &s, &c);
        tab[2 * i] = c; tab[2 * i + 1] = s;
    }
    __syncthreads();
    const int rsub = tid >> 6, t64 = tid & 63;
    const int ch0 = t64 * 8;
    float w0[8], w1[8], w2[8], cb[8];
#pragma unroll
    for (int j = 0; j < 8; ++j) { w0[j] = p.conv_w[ch0 + j]; w1[j] = p.conv_w[512 + ch0 + j]; w2[j] = p.conv_w[1024 + ch0 + j]; cb[j] = p.conv_b[ch0 + j]; }
    const float qs = ch0 < 256 ? 0.125f : 1.0f;
    const int grp = t64 >> 1, half = t64 & 1;
    const int cA = grp * 32 + half * 8;
    const int which = grp >> 4, axis = grp & 1;
    const float sc = which == 0 ? 0.18033688011112042f : 1.0f;
    for (int chunk = bid_op(); chunk < T / 16; chunk += gridDim.x) {
        const int row0 = chunk * 16;
        const bool isctx = row0 < TCTX;
        const int seq0 = isctx ? (row0 & 255) : ((row0 - TCTX) & 4095);
        const int seqlen = isctx ? CTXL : SEQ;
        u32x4 xm[2], x0[2], xp[2], ra[2], rb[2];
#pragma unroll
        for (int hh = 0; hh < 2; ++hh) {
            const int i = rsub + 8 * hh, row = row0 + i, t = seq0 + i;
            const bf16_t* src = P + (size_t)row * PLD + 1536 + ch0;
            xm[hh] = *(const u32x4*)(src - (t > 0 ? PLD : 0));
            x0[hh] = *(const u32x4*)src;
            xp[hh] = *(const u32x4*)(src + (t + 1 < seqlen ? PLD : 0));
            const bf16_t* r = P + (size_t)row * PLD + cA;
            ra[hh] = *(const u32x4*)r; rb[hh] = *(const u32x4*)(r + 16);
        }
        asm volatile("" ::: "memory");
#pragma unroll
        for (int hh = 0; hh < 2; ++hh) {
            const int i = rsub + 8 * hh, row = row0 + i, t = seq0 + i;
            {
                const bool hm = t > 0, hp = t + 1 < seqlen;
                u32x4 o;
#pragma unroll
                for (int j = 0; j < 4; ++j) {
                    const unsigned m_ = hm ? xm[hh][j] : 0u, p_ = hp ? xp[hh][j] : 0u, c_ = x0[hh][j];
                    const float y0 = w0[2 * j] * bf2f((bf16_t)(m_ & 0xffffu)) + w1[2 * j] * bf2f((bf16_t)(c_ & 0xffffu)) + w2[2 * j] * bf2f((bf16_t)(p_ & 0xffffu)) + cb[2 * j];
                    const float y1 = w0[2 * j + 1] * bf2f((bf16_t)(m_ >> 16)) + w1[2 * j + 1] * bf2f((bf16_t)(c_ >> 16)) + w2[2 * j + 1] * bf2f((bf16_t)(p_ >> 16)) + cb[2 * j + 1];
                    o[j] = pack2(siluf(y0) * qs, siluf(y1) * qs);
                }
                *(u32x4*)(QKC + (size_t)row * 512 + ch0) = o;
            }
            if (!isctx || which == 0) {
                bf16_t* r = P + (size_t)row * PLD + cA;
                const u32x4 a = ra[hh], b = rb[hh];
                const int pos = axis == 0 ? (t >> 6) : (t & 63);
                u32x4 oa, ob;
#pragma unroll
                for (int j = 0; j < 4; ++j) {
                    float a0 = bf2f((bf16_t)(a[j] & 0xffffu)), a1 = bf2f((bf16_t)(a[j] >> 16)), b0 = bf2f((bf16_t)(b[j] & 0xffffu)), b1 = bf2f((bf16_t)(b[j] >> 16));
                    if (!isctx) {
                        const int f0 = half * 8 + 2 * j;
                        const float c0 = tab[2 * (pos * 16 + f0)], s0 = tab[2 * (pos * 16 + f0) + 1], c1 = tab[2 * (pos * 16 + f0 + 1)], s1 = tab[2 * (pos * 16 + f0 + 1) + 1];
                        const float na0 = a0 * c0 - b0 * s0, nb0 = b0 * c0 + a0 * s0, na1 = a1 * c1 - b1 * s1, nb1 = b1 * c1 + a1 * s1;
                        a0 = na0; b0 = nb0; a1 = na1; b1 = nb1;
                    }
                    oa[j] = pack2(a0 * sc, a1 * sc); ob[j] = pack2(b0 * sc, b1 * sc);
                }
                *(u32x4*)r = oa; *(u32x4*)(r + 16) = ob;
            }
        }
    }
}

DI void attn_item(const Params& p, int item, unsigned char* smem, float lam) {
    const int tid = tid_op(), wid = tid >> 6, lane = tid & 63, fr = lane & 15, fq = lane >> 4;
    const bf16_t* P = (const bf16_t*)(p.ws + WS_PH);
    bf16_t* HB = (bf16_t*)(p.ws + WS_HB);
    constexpr int KLD = 136, VLD = 144, BUF = 64 * KLD + 64 * VLD;
    bf16_t* L0 = (bf16_t*)smem;
    int b, h, qrow0, nkt; bool isctx = item >= 1024;
    if (!isctx) { b = item >> 7; h = (item >> 5) & 3; const int qb = item & 31; qrow0 = TCTX + b * SEQ + qb * 128; nkt = 68; }
    else { const int it = item - 1024; b = it >> 3; h = (it >> 1) & 3; const int qb = it & 1; qrow0 = b * CTXL + qb * 128; nkt = 4; }
    const int qrow = qrow0 + wid * 16 + fr;
    bf16x8 Qf[2][2];
#pragma unroll
    for (int c = 0; c < 2; ++c)
#pragma unroll
        for (int ks = 0; ks < 2; ++ks) Qf[c][ks] = *(const bf16x8*)(P + (size_t)qrow * PLD + h * 128 + c * 64 + ks * 32 + 8 * fq);
    f32x4 O[2][8];
#pragma unroll
    for (int c = 0; c < 2; ++c)
#pragma unroll
        for (int e = 0; e < 8; ++e) O[c][e] = (f32x4){0.f, 0.f, 0.f, 0.f};
    float mrun[2] = {-1e30f, -1e30f};
    f32x4 Lacc[2] = {(f32x4){0.f, 0.f, 0.f, 0.f}, (f32x4){0.f, 0.f, 0.f, 0.f}};
    const bf16x8 ones = (bf16x8){0x3F80, 0x3F80, 0x3F80, 0x3F80, 0x3F80, 0x3F80, 0x3F80, 0x3F80};
    const int skey[2] = {tid >> 4, (tid >> 4) + 32}; const int sc8 = (tid & 15) * 8;
    u32x4 kreg[2], vreg[2];
    auto krow = [&](int kt, int key) -> size_t { return (size_t)(kt < 4 ? b * CTXL + kt * 64 + key : TCTX + b * SEQ + (kt - 4) * 64 + key); };
    auto prefetch = [&](int kt) {
#pragma unroll
        for (int i = 0; i < 2; ++i) {
            const bf16_t* rp = P + krow(kt, skey[i]) * PLD + h * 128 + sc8;
            kreg[i] = *(const u32x4*)(rp + 512);
            vreg[i] = *(const u32x4*)(rp + 1024);
        }
    };
    auto stage = [&](int buf) {
        bf16_t* Kb = L0 + buf * BUF; bf16_t* Vb = Kb + 64 * KLD;
#pragma unroll
        for (int i = 0; i < 2; ++i) { *(u32x4*)(Kb + skey[i] * KLD + sc8) = kreg[i]; *(u32x4*)(Vb + skey[i] * VLD + sc8) = vreg[i]; }
    };
    prefetch(0); stage(0);
    if (nkt > 1) prefetch(1);
    lds_barrier();
    for (int kt = 0; kt < nkt; ++kt) {
        if (kt + 1 < nkt) stage((kt + 1) & 1);
        if (kt + 2 < nkt) prefetch(kt + 2);
        const bf16_t* Ks = L0 + (kt & 1) * BUF; const bf16_t* Vs = Ks + 64 * KLD;
        bf16x8 pf[2][2];
#pragma unroll
        for (int c = 0; c < 2; ++c) {
            f32x4 s[4];
#pragma unroll
            for (int sub = 0; sub < 4; ++sub) {
                s[sub] = (f32x4){0.f, 0.f, 0.f, 0.f};
#pragma unroll
                for (int ks = 0; ks < 2; ++ks) s[sub] = mfma16(ldfrag(Ks, KLD, sub * 16 + fr, c * 64 + ks * 32 + 8 * fq), Qf[c][ks], s[sub]);
            }
            float mx = fmaxf(fmaxf(s[0][0], s[0][1]), fmaxf(s[0][2], s[0][3]));
#pragma unroll
            for (int sub = 1; sub < 4; ++sub) mx = fmaxf(mx, fmaxf(fmaxf(s[sub][0], s[sub][1]), fmaxf(s[sub][2], s[sub][3])));
            mx = fmaxf(mx, __shfl_xor(mx, 16)); mx = fmaxf(mx, __shfl_xor(mx, 32));
            if (__builtin_amdgcn_ballot_w64(mx > mrun[c] + 8.0f) != 0ull) {
                const float mnew = fmaxf(mrun[c], mx), alpha = __builtin_amdgcn_exp2f(mrun[c] - mnew);
                mrun[c] = mnew; Lacc[c] *= alpha;
#pragma unroll
                for (int e = 0; e < 8; ++e) O[c][e] *= alpha;
            }
            const float mref = mrun[c];
#pragma unroll
            for (int sub = 0; sub < 4; ++sub)
#pragma unroll
                for (int j = 0; j < 4; ++j) s[sub][j] = __builtin_amdgcn_exp2f(s[sub][j] - mref);
#pragma unroll
            for (int s2 = 0; s2 < 2; ++s2) {
                u32x4 pk;
                pk[0] = pack2(s[2 * s2][0], s[2 * s2][1]); pk[1] = pack2(s[2 * s2][2], s[2 * s2][3]);
                pk[2] = pack2(s[2 * s2 + 1][0], s[2 * s2 + 1][1]); pk[3] = pack2(s[2 * s2 + 1][2], s[2 * s2 + 1][3]);
                pf[c][s2] = __builtin_bit_cast(bf16x8, pk);
            }
        }
        const int voff = (4 * fq + (fr >> 2)) * VLD + 4 * (fr & 3);
#pragma unroll
        for (int e = 0; e < 8; ++e)
#pragma unroll
            for (int s2 = 0; s2 < 2; ++s2) {
                const s16x4 lo = __builtin_amdgcn_ds_read_tr16_b64_v4i16((LAS s16x4*)(LAS unsigned char*)(unsigned char*)(Vs + voff + (32 * s2) * VLD + 16 * e));
                const s16x4 hi = __builtin_amdgcn_ds_read_tr16_b64_v4i16((LAS s16x4*)(LAS unsigned char*)(unsigned char*)(Vs + voff + (32 * s2 + 16) * VLD + 16 * e));
                const bf16x8 vf = __builtin_shufflevector(lo, hi, 0, 1, 2, 3, 4, 5, 6, 7);
                O[0][e] = mfma16(vf, pf[0][s2], O[0][e]);
                O[1][e] = mfma16(vf, pf[1][s2], O[1][e]);
            }
#pragma unroll
        for (int s2 = 0; s2 < 2; ++s2) { Lacc[0] = mfma16(ones, pf[0][s2], Lacc[0]); Lacc[1] = mfma16(ones, pf[1][s2], Lacc[1]); }
        lds_barrier();
    }
    const float i0 = 1.f / Lacc[0][0], i1 = lam / Lacc[1][0];
    float ss = 0.f;
#pragma unroll
    for (int e = 0; e < 8; ++e)
#pragma unroll
        for (int j = 0; j < 4; ++j) { const float v = O[0][e][j] * i0 - O[1][e][j] * i1; O[0][e][j] = v; ss += v * v; }
    ss += __shfl_xor(ss, 16); ss += __shfl_xor(ss, 32);
    const float rstd = rsqrtf(ss * (1.f / 128.f) + EPS) * 0.8f;
#pragma unroll
    for (int e = 0; e < 8; ++e) {
        const f32x4 g = *(const f32x4*)(p.diff_norm_g + e * 16 + 4 * fq);
        u32x2 o; o[0] = pack2(O[0][e][0] * rstd * g[0], O[0][e][1] * rstd * g[1]); o[1] = pack2(O[0][e][2] * rstd * g[2], O[0][e][3] * rstd * g[3]);
        *(u32x2*)(HB + (size_t)qrow * D + h * 128 + e * 16 + 4 * fq) = o;
    }
}

DI void mlstm_scan(const Params& p, int sb, unsigned char* smem) {
    const int tid = tid_op(), wid = tid >> 6, lane = tid & 63, fr = lane & 15, fq = lane >> 4;
    const int b = sb >> 3, h = (sb >> 1) & 3, dir = sb & 1;
    const bf16_t* P = (const bf16_t*)(p.ws + WS_PH);
    const bf16_t* QKC = (const bf16_t*)(p.ws + WS_SC);
    bf16_t* MO = (bf16_t*)(p.ws + WS_SC) + (size_t)(1 + dir) * T * 512;
    const float* GT = (const float*)(p.ws + WS_GATES);
    bf16_t* Qs = (bf16_t*)smem; bf16_t* Ks = Qs + 64 * 72; bf16_t* KwT = Ks + 64 * 72; bf16_t* VT = KwT + 64 * 72  ; bf16_t* Sw = VT + 64 * 136; bf16_t* Cb = Sw + 64 * 72;
    float* fa = (float*)(Cb + 2 * 128 * 72);
    float* s_bc = fa; float* s_ic = fa + 64; float* s_mt = fa + 128; float* s_wi = fa + 192; float* s_wk = fa + 256; float* s_nv = fa + 320; float* s_qn = fa + 384; float* s_rsp = fa + 448;   float* s_sc = fa + 704;
    for (int i = tid; i < 2 * 128 * 72; i += NTHREADS) Cb[i] = 0;
    if (tid < 64) s_nv[tid] = 0.f;
    f32x4 Cacc[4] = {(f32x4){0.f, 0.f, 0.f, 0.f}, (f32x4){0.f, 0.f, 0.f, 0.f}, (f32x4){0.f, 0.f, 0.f, 0.f}, (f32x4){0.f, 0.f, 0.f, 0.f}};
    float mstate = 0.f;
    const int tr = wid >> 1, tc0 = (wid & 1) * 2;
    auto chunk_row0 = [&](int ci) -> int { return ci < 4 ? b * CTXL + (dir ? 3 - ci : ci) * 64 : TCTX + b * SEQ + (dir ? 63 - (ci - 4) : ci - 4) * 64; };
    auto pos_row = [&](int r0, int i) -> int { return r0 + (dir ? 63 - i : i); };
    u32x4 qreg, kreg, vreg[2]; float gi = 0.f, gf = 0.f;
    const int vrow[2] = {tid >> 4, (tid >> 4) + 32}; const int vcol = (tid & 15) * 8;
    const int qi = tid >> 3, qc8 = (tid & 7) * 8;
    auto prefetch = [&](int ci) {
        const int r0 = chunk_row0(ci);
        qreg = *(const u32x4*)(QKC + (size_t)pos_row(r0, qi) * 512 + h * 64 + qc8);
        kreg = *(const u32x4*)(QKC + (size_t)pos_row(r0, qi) * 512 + 256 + h * 64 + qc8);
        vreg[0] = *(const u32x4*)(P + (size_t)pos_row(r0, vrow[0]) * PLD + 2048 + h * 128 + vcol); vreg[1] = *(const u32x4*)(P + (size_t)pos_row(r0, vrow[1]) * PLD + 2048 + h * 128 + vcol);
        if (tid < 64) { const float* g = GT + (size_t)pos_row(r0, tid) * 16; gi = g[dir * 4 + h]; gf = g[(2 + dir) * 4 + h]; }
    };
    prefetch(0);
    int cur = 0;
    for (int ci = 0; ci < 68; ++ci) {
        const int r0 = chunk_row0(ci);
        lds_barrier();
        *(u32x4*)(Qs + qi * 72 + qc8) = qreg;
        *(u32x4*)(Ks + qi * 72 + qc8) = kreg;
        *(u32x4*)(VT + vrow[0] * 136 + vcol) = vreg[0]; *(u32x4*)(VT + vrow[1] * 136 + vcol) = vreg[1];
        if (wid == 0) {
            const float f = logsigf(gf);
            float bc = f;
            for (int o = 1; o < 64; o <<= 1) { const float t = __shfl_up(bc, o); if (lane >= o) bc += t; }
            const float bl = __shfl(bc, 63);
            float pm = gi - bc;
            for (int o = 1; o < 64; o <<= 1) { const float t = __shfl_up(pm, o); if (lane >= o) pm = fmaxf(pm, t); }
            const float mt = bc + fmaxf(mstate, pm);
            const float wi = __expf(bc + mstate - mt);
            const float g = bl - bc + gi;
            const float gmax = wave_max(g);
            const float mnew = fmaxf(bl + mstate, gmax);
            const float wk = __expf(g - mnew);
            const float decay = __expf(bl + mstate - mnew);
            s_bc[lane] = bc; s_ic[lane] = gi; s_mt[lane] = mt; s_wi[lane] = wi; s_wk[lane] = wk;
            if (lane == 0) s_sc[0] = decay;
            mstate = mnew;
        }
        lds_barrier();
        if (ci + 1 < 68) prefetch(ci + 1);
        {
            const int s = tid & 63, d8 = (tid >> 6) * 8; const float wk = s_wk[s];
            const int sslot = 32 * (s >> 5) + 8 * ((s >> 2) & 3) + 4 * ((s >> 4) & 1) + (s & 3);
            const u32x4 kv = *(const u32x4*)(Ks + s * 72 + d8);
#pragma unroll
            for (int j = 0; j < 4; ++j) { KwT[(d8 + 2 * j) * 72 + sslot] = f2bf(bf2f((bf16_t)(kv[j] & 0xffffu)) * wk); KwT[(d8 + 2 * j + 1) * 72 + sslot] = f2bf(bf2f((bf16_t)(kv[j] >> 16)) * wk); }
        }
        {
            const int t = tid >> 3, part = tid & 7; float a = 0.f;
#pragma unroll
            for (int j = 0; j < 8; ++j) a += bf2f(Qs[t * 72 + part * 8 + j]) * s_nv[part * 8 + j];
            a += __shfl_xor(a, 1); a += __shfl_xor(a, 2); a += __shfl_xor(a, 4);
            if (part == 0) s_qn[t] = a;
        }
#pragma unroll
        for (int k2 = 0; k2 < 2; ++k2) {
            const int tc = tc0 + k2; const int t = tr * 16 + fr;
            f32x4 a = (f32x4){0.f, 0.f, 0.f, 0.f};
            if (tc <= tr) {
#pragma unroll
                for (int ks = 0; ks < 2; ++ks) a = mfma16(ldfrag(Ks, 72, tc * 16 + fr, ks * 32 + 8 * fq), ldfrag(Qs, 72, t, ks * 32 + 8 * fq), a);
                const float bt = s_bc[t] - s_mt[t];
#pragma unroll
                for (int j = 0; j < 4; ++j) { const int s = tc * 16 + 4 * fq + j; a[j] = (s <= t) ? a[j] * __expf(bt - s_bc[s] + s_ic[s]) : 0.f; }
            }
            float rs = a[0] + a[1] + a[2] + a[3];
            rs += __shfl_xor(rs, 16); rs += __shfl_xor(rs, 32);
            if (fq == 0) s_rsp[tc * 64 + t] = rs;
            u32x2 o; o[0] = pack2(a[0], a[1]); o[1] = pack2(a[2], a[3]);
            *(u32x2*)(Sw + t * 72 + 32 * (tc >> 1) + 8 * fq + 4 * (tc & 1)) = o;
        }
        lds_barrier();
        const float decay = s_sc[0];
        const bf16_t* Cc = Cb + cur * 128 * 72; bf16_t* Cn = Cb + (cur ^ 1) * 128 * 72;
        auto vfrag = [&](int et, int ks) -> bf16x8 {
            const bf16_t* base = VT + (32 * ks + 4 * fq + (fr >> 2)) * 136 + 16 * et + 4 * (fr & 3);
            const s16x4 lo = __builtin_amdgcn_ds_read_tr16_b64_v4i16((LAS s16x4*)(LAS unsigned char*)(unsigned char*)base);
            const s16x4 hi = __builtin_amdgcn_ds_read_tr16_b64_v4i16((LAS s16x4*)(LAS unsigned char*)(unsigned char*)(base + 16 * 136));
            return __builtin_shufflevector(lo, hi, 0, 1, 2, 3, 4, 5, 6, 7);
        };
        const int ec0 = (wid & 1) * 4;
        {
            const int t = tr * 16 + fr;
            const float wi = s_wi[t];
            const float den = s_rsp[t] + s_rsp[64 + t] + s_rsp[128 + t] + s_rsp[192 + t] + wi * s_qn[t];
            const float dn = 1.f / fmaxf(fabsf(den), __expf(-s_mt[t]));
#pragma unroll
            for (int k4 = 0; k4 < 4; ++k4) {
                const int tc = ec0 + k4;
                f32x4 a1 = (f32x4){0.f, 0.f, 0.f, 0.f}, a2 = (f32x4){0.f, 0.f, 0.f, 0.f};
#pragma unroll
                for (int ks = 0; ks < 2; ++ks) {
                    a1 = mfma16(vfrag(tc, ks), ldfrag(Sw, 72, t, ks * 32 + 8 * fq), a1);
                    a2 = mfma16(ldfrag(Cc, 72, tc * 16 + fr, ks * 32 + 8 * fq), ldfrag(Qs, 72, t, ks * 32 + 8 * fq), a2);
                }
                u32x2 o; o[0] = pack2((a1[0] + wi * a2[0]) * dn, (a1[1] + wi * a2[1]) * dn); o[1] = pack2((a1[2] + wi * a2[2]) * dn, (a1[3] + wi * a2[3]) * dn);
                *(u32x2*)(MO + (size_t)pos_row(r0, t) * 512 + h * 128 + tc * 16 + 4 * fq) = o;
            }
        }
#pragma unroll
        for (int k4 = 0; k4 < 4; ++k4) {
            const int tc = ec0 + k4;
            f32x4 a = Cacc[k4] * decay;
#pragma unroll
            for (int ks = 0; ks < 2; ++ks) a = mfma16(ldfrag(KwT, 72, tr * 16 + fr, ks * 32 + 8 * fq), vfrag(tc, ks), a);
            Cacc[k4] = a;
            u32x2 o; o[0] = pack2(a[0], a[1]); o[1] = pack2(a[2], a[3]);
            *(u32x2*)(Cn + (tc * 16 + fr) * 72 + tr * 16 + 4 * fq) = o;
        }
        {
            const int d = tid >> 3, part = tid & 7; float a = 0.f;
#pragma unroll
            for (int j = 0; j < 8; ++j) { const int s = part * 8 + j; a += s_wk[s] * bf2f(Ks[s * 72 + d]); }
            a += __shfl_xor(a, 1); a += __shfl_xor(a, 2); a += __shfl_xor(a, 4);
            if (part == 0) s_nv[d] = decay * s_nv[d] + a;
        }
        cur ^= 1;
    }
    lds_barrier();
}

DI void phase_a0(const Params& p, unsigned char* smem, int rep) {
    __shared__ int s_item;
    float l1 = 0.f, l2 = 0.f;
    for (int i = 0; i < 64; ++i) { l1 += p.diff_lambda[i] * p.diff_lambda[64 + i]; l2 += p.diff_lambda[128 + i] * p.diff_lambda[192 + i]; }
    const float lam = expf(l1) - expf(l2) + 0.2f;
    #ifdef A0_MODE
    if (rep == 0 || (A0_MODE & 1))
#endif
    { const int bb = bid_op(); if (bb < 64) mlstm_scan(p, bb, smem); }
#ifdef A0_MODE
    if (rep == 1 && !(A0_MODE & 2)) return;
#endif
    unsigned* ctr = (unsigned*)(p.ws + WS_CTL) + 3584 + 1024 * rep;
    const unsigned myx = ((unsigned)__builtin_amdgcn_s_getreg((3 << 11) | 20)) & 7u;
    for (unsigned k = 0; k < 8; ++k) {
        const unsigned x = (myx + k) & 7u;
        for (;;) {
            __syncthreads();
            if (tid_op() == 0) s_item = (int)atomicAdd(ctr + 64 * x, 1u);
            __syncthreads();
            const int j = s_item;
            if (j >= 136) break;
            const int G = (int)x * 4 + j / 34, r = j % 34;
            const int item = r < 32 ? G * 32 + r : 1024 + G * 2 + (r - 32);
            attn_item(p, item, smem, lam);
        }
    }
}

DI void phase_m0(const Params& p) {
    const int tid = tid_op(); const int lane = tid & 63, gw = bid_op() * 8 + (tid >> 6), nw = gridDim.x * 8;
    const bf16_t* P = (const bf16_t*)(p.ws + WS_PH);
    const bf16_t* MF = (const bf16_t*)(p.ws + WS_SC) + (size_t)T * 512; const bf16_t* MB = MF + (size_t)T * 512;
    bf16_t* HB = (bf16_t*)(p.ws + WS_HB);
    for (int row = gw; row < T; row += nw) {
        const int c0 = lane * 8;
        const u32x4 a = *(const u32x4*)(MF + (size_t)row * 512 + c0), bb = *(const u32x4*)(MB + (size_t)row * 512 + c0);
        const u32x4 op = *(const u32x4*)(P + (size_t)row * PLD + 2560 + c0);
        float v[8]; float ss = 0.f;
#pragma unroll
        for (int j = 0; j < 4; ++j) {
            v[2 * j] = bf2f((bf16_t)(a[j] & 0xffffu)) + bf2f((bf16_t)(bb[j] & 0xffffu)); v[2 * j + 1] = bf2f((bf16_t)(a[j] >> 16)) + bf2f((bf16_t)(bb[j] >> 16));
            ss += v[2 * j] * v[2 * j] + v[2 * j + 1] * v[2 * j + 1];
        }
        ss += __shfl_xor(ss, 1); ss += __shfl_xor(ss, 2); ss += __shfl_xor(ss, 4); ss += __shfl_xor(ss, 8);
        const float rstd = rsqrtf(ss * (1.f / 128.f) + EPS);
        u32x4 o;
#pragma unroll
        for (int j = 0; j < 4; ++j) {
            const float o0 = v[2 * j] * rstd * p.ml_norm_g[c0 + 2 * j] * sigmoidf(bf2f((bf16_t)(op[j] & 0xffffu)));
            const float o1 = v[2 * j + 1] * rstd * p.ml_norm_g[c0 + 2 * j + 1] * sigmoidf(bf2f((bf16_t)(op[j] >> 16)));
            o[j] = pack2(o0, o1);
        }
        *(u32x4*)(HB + (size_t)row * D + 512 + c0) = o;
    }
}

DI void phase_e1(const Params& p, unsigned char* smem) {
    const int tid = tid_op();
    const bf16_t* P = (const bf16_t*)(p.ws + WS_PH);
    bf16_t* LA = (bf16_t*)(p.ws + WS_HB);
    float* lrs = (float*)smem;
    const int c2 = (tid & 255) * 2, rh = tid >> 8;
    float wf[16][2], wb[16][2];
#pragma unroll
    for (int r = 0; r < 16; ++r) { wf[r][0] = p.gla_w_gate[r * 512 + c2]; wf[r][1] = p.gla_w_gate[r * 512 + c2 + 1]; wb[r][0] = p.gla_w_gate[(16 + r) * 512 + c2]; wb[r][1] = p.gla_w_gate[(16 + r) * 512 + c2 + 1]; }
    const float bf0 = p.gla_b_gate[c2], bf1 = p.gla_b_gate[c2 + 1], bb0 = p.gla_b_gate[512 + c2], bb1 = p.gla_b_gate[512 + c2 + 1];
    for (int chunk = bid_op(); chunk < T / 16; chunk += gridDim.x) {
        const int row0 = chunk * 16;
        __syncthreads();
        if (tid < 128) { const int rr = tid >> 3, c4 = (tid & 7) * 4;
          const u32x2 v = *(const u32x2*)(P + (size_t)(row0 + rr) * PLD + 3072 + c4);
          lrs[rr * 32 + c4] = bf2f((bf16_t)(v[0] & 0xffffu)); lrs[rr * 32 + c4 + 1] = bf2f((bf16_t)(v[0] >> 16)); lrs[rr * 32 + c4 + 2] = bf2f((bf16_t)(v[1] & 0xffffu)); lrs[rr * 32 + c4 + 3] = bf2f((bf16_t)(v[1] >> 16)); }
        __syncthreads();
#pragma unroll 2
        for (int it = 0; it < 8; ++it) {
            const int i = 2 * it + rh;
            float zf0 = bf0, zf1 = bf1, zb0 = bb0, zb1 = bb1;
#pragma unroll
            for (int r = 0; r < 16; ++r) { const float a = lrs[i * 32 + r], b = lrs[i * 32 + 16 + r]; zf0 += a * wf[r][0]; zf1 += a * wf[r][1]; zb0 += b * wb[r][0]; zb1 += b * wb[r][1]; }
            *(unsigned*)(LA + (size_t)(row0 + i) * 512 + c2) = pack2(logsigf(zf0) * (1.f / 16.f), logsigf(zf1) * (1.f / 16.f));
            *(unsigned*)(LA + (size_t)T * 512 + (size_t)(row0 + i) * 512 + c2) = pack2(logsigf(zb0) * (1.f / 16.f), logsigf(zb1) * (1.f / 16.f));
        }
    }
}

DI void phase_s1(const Params& p, unsigned char* smem) {
    const int tid = tid_op(), wid = tid >> 6, lane = tid & 63, fr = lane & 15, fq = lane >> 4;
    const bf16_t* P = (const bf16_t*)(p.ws + WS_PH);
    bf16_t* Qe = (bf16_t*)smem;
    bf16_t* Ke = Qe + 64 * 136;
    bf16_t* LAs = Ke + 64 * 136;
    bf16_t* KdT = LAs + 64 * 144;
    bf16_t* VT = KdT + 128 * 72;
    bf16_t* Am = VT + 64 * 72;
    bf16_t* St = Am + 64 * 72;
    float* s_bl = (float*)(St + 2 * 64 * 136);
    for (int sb = bid_op(); sb < 256; sb += gridDim.x) {
        const int b = sb >> 5, h = (sb >> 3) & 3, dir = (sb >> 2) & 1, es = sb & 3;
        const bf16_t* LA = (const bf16_t*)(p.ws + WS_HB) + (size_t)dir * T * 512;
        bf16_t* OO = (bf16_t*)(p.ws + WS_SC) + (size_t)dir * T * D;
        lds_barrier();
        for (int i = tid; i < 2 * 64 * 136; i += NTHREADS) St[i] = 0;
        f32x4 Sacc[4];
#pragma unroll
        for (int k = 0; k < 4; ++k) Sacc[k] = (f32x4){0.f, 0.f, 0.f, 0.f};
        auto chunk_row0 = [&](int ci) -> int { return ci < 4 ? b * CTXL + (dir ? 3 - ci : ci) * 64 : TCTX + b * SEQ + (dir ? 63 - (ci - 4) : ci - 4) * 64; };
        auto pos_row = [&](int r0, int i) -> int { return r0 + (dir ? 63 - i : i); };
        const int pr[2] = {tid >> 4, (tid >> 4) + 32}; const int pc = (tid & 15) * 8; const int vr = tid >> 3, vc = (tid & 7) * 8;
        u32x4 qA[2], kA[2], lA[2], vA, qB[2], kB[2], lB[2], vB;
        auto prefetch = [&](int ci, u32x4 (&qreg)[2], u32x4 (&kreg)[2], u32x4 (&lreg)[2], u32x4& vreg) {
            const int r0p = chunk_row0(ci);
#pragma unroll
            for (int i = 0; i < 2; ++i) {
                const size_t row = (size_t)pos_row(r0p, pr[i]);
                qreg[i] = *(const u32x4*)(P + row * PLD + h * 128 + pc);
                kreg[i] = *(const u32x4*)(P + row * PLD + 512 + h * 128 + pc);
                lreg[i] = *(const u32x4*)(LA + row * 512 + h * 128 + pc);
            }
            vreg = *(const u32x4*)(P + (size_t)pos_row(r0p, vr) * PLD + 1024 + h * 256 + es * 64 + vc);
        };
        prefetch(0, qA, kA, lA, vA);
        int cur = 0;
        auto step = [&](int ci, u32x4 (&qreg)[2], u32x4 (&kreg)[2], u32x4 (&lreg)[2], u32x4& vreg, u32x4 (&qn)[2], u32x4 (&kn)[2], u32x4 (&ln)[2], u32x4& vn) {
            const int r0 = chunk_row0(ci);
            lds_barrier();
            if (ci + 1 < 68) prefetch(ci + 1, qn, kn, ln, vn);
#pragma unroll
            for (int i = 0; i < 2; ++i) {
                *(u32x4*)(Qe + pr[i] * 136 + pc) = qreg[i];
                *(u32x4*)(Ke + pr[i] * 136 + pc) = kreg[i];
                *(u32x4*)(LAs + pr[i] * 144 + pc) = lreg[i];
            }
            *(u32x4*)(VT + vr * 72 + vc) = vreg;
            lds_barrier();
            {
                bf16x8 laf[2];
#pragma unroll
                for (int ks = 0; ks < 2; ++ks) {
                    const bf16_t* base = LAs + (32 * ks + 4 * fq + (fr >> 2)) * 144 + 16 * wid + 4 * (fr & 3);
                    const s16x4 lo = __builtin_amdgcn_ds_read_tr16_b64_v4i16((LAS s16x4*)(LAS unsigned char*)(unsigned char*)base);
                    const s16x4 hi = __builtin_amdgcn_ds_read_tr16_b64_v4i16((LAS s16x4*)(LAS unsigned char*)(unsigned char*)(base + 16 * 144));
                    laf[ks] = __builtin_shufflevector(lo, hi, 0, 1, 2, 3, 4, 5, 6, 7);
                }
                const bf16x8 ones = (bf16x8){0x3F80, 0x3F80, 0x3F80, 0x3F80, 0x3F80, 0x3F80, 0x3F80, 0x3F80};
                f32x4 blt = (f32x4){0.f, 0.f, 0.f, 0.f};
#pragma unroll
                for (int ks = 0; ks < 2; ++ks) blt = mfma16(laf[ks], ones, blt);
                float ebl[4];
#pragma unroll
                for (int j = 0; j < 4; ++j) ebl[j] = __expf(blt[j]);
                if (fr == 0) { *(f32x4*)(s_bl + 16 * wid + 4 * fq) = blt; }
#pragma unroll
                for (int ti = 0; ti < 4; ++ti) {
                    const int i = 16 * ti + fr;
                    const int islot = 32 * (i >> 5) + 8 * ((i >> 2) & 3) + 4 * ((i >> 4) & 1) + (i & 3);
                    f32x4 bc = (f32x4){0.f, 0.f, 0.f, 0.f};
#pragma unroll
                    for (int ks = 0; ks < 2; ++ks) {
                        bf16x8 tri;
#pragma unroll
                        for (int e = 0; e < 8; ++e) { const int jpos = 32 * ks + 16 * (e >> 2) + 4 * fq + (e & 3); tri[e] = (jpos <= i) ? (short)0x3F80 : (short)0; }
                        bc = mfma16(laf[ks], tri, bc);
                    }
                    const int d0 = 16 * wid + 4 * fq;
                    const u32x2 qv = *(const u32x2*)(Qe + i * 136 + d0), kv = *(const u32x2*)(Ke + i * 136 + d0);
                    float qf[4] = {bf2f((bf16_t)(qv[0] & 0xffffu)), bf2f((bf16_t)(qv[0] >> 16)), bf2f((bf16_t)(qv[1] & 0xffffu)), bf2f((bf16_t)(qv[1] >> 16))};
                    float kf[4] = {bf2f((bf16_t)(kv[0] & 0xffffu)), bf2f((bf16_t)(kv[0] >> 16)), bf2f((bf16_t)(kv[1] & 0xffffu)), bf2f((bf16_t)(kv[1] >> 16))};
                    float qo[4], ko[4];
#pragma unroll
                    for (int j = 0; j < 4; ++j) {
                        const float E = __expf(bc[j]), R = __expf(-bc[j]);
                        qo[j] = qf[j] * 0.08838834764831845f * E; ko[j] = kf[j] * R;
                        KdT[(d0 + j) * 72 + islot] = f2bf(ko[j] * ebl[j]);
                    }
                    u32x2 qw, kw; qw[0] = pack2(qo[0], qo[1]); qw[1] = pack2(qo[2], qo[3]); kw[0] = pack2(ko[0], ko[1]); kw[1] = pack2(ko[2], ko[3]);
                    *(u32x2*)(Qe + i * 136 + d0) = qw; *(u32x2*)(Ke + i * 136 + d0) = kw;
                }
            }
            lds_barrier();
            const int tr = wid >> 1, tc0 = (wid & 1) * 2;
#pragma unroll
            for (int k2 = 0; k2 < 2; ++k2) {
                const int tc = tc0 + k2; const int t = tr * 16 + fr;
                f32x4 a = (f32x4){0.f, 0.f, 0.f, 0.f};
                if (tc <= tr) {
#pragma unroll
                    for (int ks = 0; ks < 4; ++ks) a = mfma16(ldfrag(Ke, 136, tc * 16 + fr, ks * 32 + 8 * fq), ldfrag(Qe, 136, t, ks * 32 + 8 * fq), a);
#pragma unroll
                    for (int j = 0; j < 4; ++j) { const int sp = tc * 16 + 4 * fq + j; if (sp > t) a[j] = 0.f; }
                }
                u32x2 o; o[0] = pack2(a[0], a[1]); o[1] = pack2(a[2], a[3]);
                *(u32x2*)(Am + t * 72 + 32 * (tc >> 1) + 8 * fq + 4 * (tc & 1)) = o;
            }
            lds_barrier();
            const bf16_t* Sc = St + cur * 64 * 136; bf16_t* Sn = St + (cur ^ 1) * 64 * 136;
            auto vfrag = [&](int et, int ks) -> bf16x8 {
                const bf16_t* base = VT + (32 * ks + 4 * fq + (fr >> 2)) * 72 + 16 * et + 4 * (fr & 3);
                const s16x4 lo = __builtin_amdgcn_ds_read_tr16_b64_v4i16((LAS s16x4*)(LAS unsigned char*)(unsigned char*)base);
                const s16x4 hi = __builtin_amdgcn_ds_read_tr16_b64_v4i16((LAS s16x4*)(LAS unsigned char*)(unsigned char*)(base + 16 * 72));
                return __builtin_shufflevector(lo, hi, 0, 1, 2, 3, 4, 5, 6, 7);
            };
            if (ci >= 4) {
#pragma unroll
                for (int k2 = 0; k2 < 2; ++k2) {
                    const int tc = tc0 + k2; const int t = tr * 16 + fr;
                    f32x4 a = (f32x4){0.f, 0.f, 0.f, 0.f};
#pragma unroll
                    for (int ks = 0; ks < 2; ++ks) a = mfma16(vfrag(tc, ks), ldfrag(Am, 72, t, ks * 32 + 8 * fq), a);
#pragma unroll
                    for (int ks = 0; ks < 4; ++ks) a = mfma16(ldfrag(Sc, 136, tc * 16 + fr, ks * 32 + 8 * fq), ldfrag(Qe, 136, t, ks * 32 + 8 * fq), a);
                    u32x2 o; o[0] = pack2(a[0], a[1]); o[1] = pack2(a[2], a[3]);
                    *(u32x2*)(OO + (size_t)pos_row(r0, t) * D + h * 256 + es * 64 + tc * 16 + 4 * fq) = o;
                }
            }
#pragma unroll
            for (int et = 0; et < 4; ++et) {
                f32x4 a = Sacc[et];
#pragma unroll
                for (int j = 0; j < 4; ++j) a[j] *= __expf(s_bl[wid * 16 + 4 * fq + j]);
#pragma unroll
                for (int ks = 0; ks < 2; ++ks) a = mfma16(ldfrag(KdT, 72, wid * 16 + fr, ks * 32 + 8 * fq), vfrag(et, ks), a);
                Sacc[et] = a;
                u32x2 o; o[0] = pack2(a[0], a[1]); o[1] = pack2(a[2], a[3]);
                *(u32x2*)(Sn + (et * 16 + fr) * 136 + wid * 16 + 4 * fq) = o;
            }
            cur ^= 1;
        };
        for (int ci = 0; ci < 68; ci += 2) { step(ci, qA, kA, lA, vA, qB, kB, lB, vB); step(ci + 1, qB, kB, lB, vB, qA, kA, lA, vA); }
    }
    lds_barrier();
}

DI void phase_m1(const Params& p) {
    const int tid = tid_op(); const int lane = tid & 63, gw = bid_op() * 8 + (tid >> 6), nw = gridDim.x * 8;
    const bf16_t* P = (const bf16_t*)(p.ws + WS_PH);
    const bf16_t* OF = (const bf16_t*)(p.ws + WS_SC); const bf16_t* OB = OF + (size_t)T * D;
    bf16_t* HB = (bf16_t*)(p.ws + WS_HB);
    for (int row = TCTX + gw; row < T; row += nw) {
        const int c0 = lane * 16;
        float v[16]; float ss = 0.f;
#pragma unroll
        for (int hlf = 0; hlf < 2; ++hlf) {
            const u32x4 a = *(const u32x4*)(OF + (size_t)row * D + c0 + hlf * 8), bb = *(const u32x4*)(OB + (size_t)row * D + c0 + hlf * 8);
#pragma unroll
            for (int j = 0; j < 4; ++j) {
                const float x0 = bf2f((bf16_t)(a[j] & 0xffffu)) + bf2f((bf16_t)(bb[j] & 0xffffu)), x1 = bf2f((bf16_t)(a[j] >> 16)) + bf2f((bf16_t)(bb[j] >> 16));
                v[hlf * 8 + 2 * j] = x0; v[hlf * 8 + 2 * j + 1] = x1; ss += x0 * x0 + x1 * x1;
            }
        }
        ss += __shfl_xor(ss, 1); ss += __shfl_xor(ss, 2); ss += __shfl_xor(ss, 4); ss += __shfl_xor(ss, 8);
        const float rstd = rsqrtf(ss * (1.f / 256.f) + EPS);
        const int gc = c0 & 255;
#pragma unroll
        for (int hlf = 0; hlf < 2; ++hlf) {
            const u32x4 rr = *(const u32x4*)(P + (size_t)row * PLD + 2048 + c0 + hlf * 8);
            u32x4 o;
#pragma unroll
            for (int j = 0; j < 4; ++j) {
                const float r0 = bf2f((bf16_t)(rr[j] & 0xffffu)), r1 = bf2f((bf16_t)(rr[j] >> 16));
                o[j] = pack2(v[hlf * 8 + 2 * j] * rstd * p.gla_norm_g[gc + hlf * 8 + 2 * j] * siluf(r0), v[hlf * 8 + 2 * j + 1] * rstd * p.gla_norm_g[gc + hlf * 8 + 2 * j + 1] * siluf(r1));
            }
            *(u32x4*)(HB + (size_t)row * D + c0 + hlf * 8) = o;
        }
    }
}

#define XB_TMO      128
#define XB_XCNT(j)  (256  + 64 * (j))
#define XB_XSUB(j)  (1280 + 64 * (j))
#define XB_XGEN(j)  (2304 + 64 * (j))
#define XB_TOP      3328
#define XB_TOPGEN   3392
#define XCD_BAR_WORDS 3456
#define XB_SPIN_CAP (1u << 18)
DI unsigned xb_ld(unsigned* p) { return __hip_atomic_load(p, __ATOMIC_RELAXED, __HIP_MEMORY_SCOPE_AGENT); }
DI unsigned xb_add(unsigned* p, unsigned v) { return __hip_atomic_fetch_add(p, v, __ATOMIC_RELAXED, __HIP_MEMORY_SCOPE_AGENT); }
DI unsigned xb_xcc_id() { return (unsigned)__builtin_amdgcn_s_getreg((3 << 11) | 20) & 0xFu; }
#define XB_SPIN(cond, bar) do { unsigned _sp = 0; while (cond) { __builtin_amdgcn_s_sleep(1); \
    if ((++_sp & 255u) == 0u) { if (xb_ld(&(bar)[XB_TMO])) break; if (_sp > XB_SPIN_CAP) { atomicAdd(&(bar)[XB_TMO], 1u); break; } } } } while (0)
struct XcdBarrier { unsigned* bar; unsigned x; volatile LAS unsigned* st; };
DI XcdBarrier xcd_barrier_post(unsigned* bar, volatile LAS unsigned* st) {
    XcdBarrier b; b.bar = bar; b.x = xb_xcc_id(); b.st = st;
    if (threadIdx.x == 0) (void)xb_add(&bar[XB_XCNT(b.x)], 1u);
    return b;
}
DI void xcd_barrier_complete(unsigned* bar, unsigned x, unsigned& nloc, unsigned& nx) {
    const unsigned G = gridDim.x * gridDim.y * gridDim.z;
    unsigned sum, cnt, mine, sp = 0u;
    for (;;) {
        sum = 0u; cnt = 0u; mine = 0u;
#pragma unroll
        for (unsigned j = 0; j < 16; ++j) { const unsigned c = xb_ld(&bar[XB_XCNT(j)]); sum += c; cnt += (c > 0u) ? 1u : 0u; mine = (j == x) ? c : mine; }
        if (sum == G) break;
        __builtin_amdgcn_s_sleep(1);
        if ((++sp & 255u) == 0u) { if (xb_ld(&bar[XB_TMO])) break; if (sp > XB_SPIN_CAP) { atomicAdd(&bar[XB_TMO], 1u); break; } }
    }
    nloc = mine > 0u ? mine : 1u; nx = cnt > 0u ? cnt : 1u;
}
DI void xcd_barrier(unsigned* bar_, unsigned char* smem_) {
    asm volatile("s_waitcnt vmcnt(0)" ::: "memory");
    __syncthreads();
    if (threadIdx.x == 0) {
        XcdBarrier b; b.bar = bar_; b.x = xb_xcc_id(); b.st = (volatile LAS unsigned*)(LAS unsigned char*)(smem_ + LDS_BYTES - 16);
        unsigned* bar = b.bar;
        __builtin_amdgcn_s_waitcnt(0);
        unsigned nloc = b.st[0], nx = b.st[1];
        if (nloc == 0u) { xcd_barrier_complete(bar, b.x, nloc, nx); b.st[0] = nloc; b.st[1] = nx; }
        const unsigned old = xb_add(&bar[XB_XSUB(b.x)], 1u);
        const unsigned gen = old / nloc;
        if (old + 1u == (gen + 1u) * nloc) {
            __builtin_amdgcn_fence(__ATOMIC_RELEASE, "agent");
            asm volatile("s_waitcnt vmcnt(0)" ::: "memory");
            const unsigned og = xb_add(&bar[XB_TOP], 1u);
            const unsigned tg = og / nx;
            if (og + 1u == (tg + 1u) * nx) xb_add(&bar[XB_TOPGEN], 1u);
            else XB_SPIN(xb_ld(&bar[XB_TOPGEN]) == tg, bar);
            __builtin_amdgcn_fence(__ATOMIC_ACQUIRE, "agent");
            xb_add(&bar[XB_XGEN(b.x)], 1u);
            asm volatile("s_waitcnt vmcnt(0)" ::: "memory");
        } else {
            XB_SPIN(xb_ld(&bar[XB_XGEN(b.x)]) == gen, bar);
            __builtin_amdgcn_fence(__ATOMIC_ACQUIRE, "agent");
            asm volatile("s_waitcnt vmcnt(0)" ::: "memory");
        }
    }
    __syncthreads();
}

constexpr int N_PHASES = 26;
#ifndef PH_MASK
#define PH_MASK 0xFFFFu
#endif
#define PH_ON(k) ((PH_MASK >> (k)) & 1u)
DI void run_phase(const Params& p, int ph, unsigned char* smem, int rep) {
    bf16_t* HB = (bf16_t*)(p.ws + WS_HB);
    bf16_t* PH = (bf16_t*)(p.ws + WS_PH);
    float* XC = (float*)(p.ws + WS_XC);
    if (ph == 0) { if (PH_ON(0)) phase_prep(p, smem); return; }
    if (ph == 25) { if (PH_ON(11)) phase_final(p.out, p.final_g); return; }
    const int l = (ph - 1) / 12, s = (ph - 1) % 12;
    const float* mods_l = (const float*)(p.ws + WS_MODS) + (size_t)l * 9 * NMOD;
    const bool first = (l == 0 && s <= 2);
    const float* src_ctx = first ? p.ctx : XC; const float* src_lat = first ? p.x : p.out;
    const int lat_only = (l == 1 && s >= 8) ? 1 : 0;
    const int row_lo = lat_only ? TCTX : 0;
    g8::StaticOrder S;
    LAS unsigned char* lds = (LAS unsigned char*)smem;
    switch (s) {
    case 0: case 3: case 9: if (PH_ON(1)) {
        const bool pend = (s == 3) || (s == 9 && l == 0) || (s == 0 && l == 1);
        const int nsl = s == 9 ? 4 : 8;
        phase_norm((s == 0 && l == 0) ? p.ctx : XC, (s == 0 && l == 0) ? p.x : p.out, HB, mods_l, p.norm_g + (size_t)(l * 3 + (s == 0 ? 0 : (s == 3 ? 1 : 2))) * D, s == 0 ? 0 : (s == 3 ? 3 : 6), s == 9 ? row_lo : 0,
                   pend ? (const bf16_t*)(p.ws + WS_SC) : nullptr, nsl, XC);
    } break;

    case 1: case 10: if (PH_ON(2)) {
        const int f = s == 1 ? 0 : 1;
        g8::Gemm g{HB + (size_t)row_lo * D, (const bf16_t*)(p.ws + WS_WFI + (size_t)(l * 2 + f) * SZ_WFI), T - row_lo, NFF, D, D};
        S.init(g.M, g.N, gridDim.x, bid_op());
        g8::EpiSwiglu E{PH, row_lo};
        g8::gemm_phase(lds, g, S, E);
    } break;
    case 2: case 11: case 8: if (PH_ON(3)) {
        const bf16_t* Ab; const bf16_t* Wb; int K; int gate_idx; float coef;
        if (s == 8) { Ab = HB; Wb = (const bf16_t*)(p.ws + WS_WMO + (size_t)l * SZ_WMO); K = D; gate_idx = 5; coef = 1.0f; }
        else { const int f = s == 2 ? 0 : 1; Ab = PH; Wb = (const bf16_t*)(p.ws + WS_WFO + (size_t)(l * 2 + f) * SZ_WFO); K = DFF; gate_idx = f == 0 ? 2 : 8; coef = 0.5f; }
        {
            g8::Gemm g{Ab + (size_t)TCTX * K, Wb, TLAT, D, K, K};
            g8::EpiResid E;
            E.src_ctx = src_ctx; E.src_lat = src_lat; E.dst_ctx = XC; E.dst_lat = p.out; E.mods = mods_l; E.row_base = TCTX; E.gate_idx = gate_idx; E.coef = coef;
            S.init(g.M, g.N, gridDim.x, bid_op());
            g8::gemm_phase(lds, g, S, E);
        }
        if (!lat_only) {
            const int nsl = K == D ? 4 : 8, nitems = 32 * nsl;
            for (int item = bid_op(); item < nitems; item += gridDim.x) {
                const int u = item / nsl, sl = item % nsl;
                int k0, kl;
                if (K == D) { k0 = sl * 256; kl = 256; } else if (sl < 6) { k0 = sl * 384; kl = 384; } else { k0 = 2304 + (sl - 6) * 256; kl = 256; }
                g8::Gemm g{Ab + k0, Wb + k0, TCTX, D, kl, K};
                g8::SingleUnit SU; SU.u.pm = u >> 2; SU.u.pn = u & 3;
                g8::EpiPartial E{(bf16_t*)(p.ws + WS_SC) + (size_t)sl * TCTX * D, mods_l + (size_t)8 * NMOD + gate_idx * D, coef};
                g8::gemm_phase(lds, g, SU, E);
            }
        }
    } break;
    case 4: if (PH_ON(4)) {
        g8::Gemm g{HB, (const bf16_t*)(p.ws + WS_WMI + (size_t)l * SZ_WMI), T, PN, D, D};
        S.init(g.M, g.N, gridDim.x, bid_op());
        g8::EpiP E{PH, l == 0 ? (float*)(p.ws + WS_GATES) : nullptr, p.gate_b};
        g8::gemm_phase(lds, g, S, E);
    } break;
    case 5: if (l == 0) { if (PH_ON(5)) phase_e0(p, smem); } else { if (PH_ON(6)) phase_e1(p, smem); } break;
    case 6: if (l == 0) { if (PH_ON(7)) phase_a0(p, smem, rep); } else { if (PH_ON(8)) phase_s1(p, smem); } break;
    case 7: if (l == 0) { if (PH_ON(9)) phase_m0(p); } else { if (PH_ON(10)) phase_m1(p); } break;
    }
}

__global__ void __launch_bounds__(NTHREADS, 2) fwd_kernel(Params p) {
    extern __shared__ __attribute__((aligned(16))) unsigned char smem[];
    if (p.coop) {
        volatile LAS unsigned* st = (volatile LAS unsigned*)(LAS unsigned char*)(smem + LDS_BYTES - 16);
        if (threadIdx.x == 0) { st[0] = 0u; st[1] = 0u; }
        __syncthreads();
        (void)xcd_barrier_post((unsigned*)(p.ws + WS_CTL), st);
    }
    for (int ph = p.ph_lo; ph < p.ph_hi; ++ph) {
        run_phase(p, ph, smem, 0);
#ifdef DUP_SYNC
        if (ph == 1) { for (int k = 0; k < 20; ++k) xcd_barrier((unsigned*)(p.ws + WS_CTL), smem); }
#endif
#ifdef DUP_PHASE
        if (ph == DUP_PHASE) { cg::this_grid().sync(); run_phase(p, ph, smem, 1); }
#endif
        if (p.coop && ph + 1 < p.ph_hi) {
            if (p.pad == 0x7fffffff) cg::this_grid().sync();
            xcd_barrier((unsigned*)(p.ws + WS_CTL), smem);
        }
    }
}

extern "C" void kernel_launch(void* const* d_in, const int* in_sizes, int n_in, void* d_out, int out_size, void* d_ws, size_t ws_size, hipStream_t stream) {
    static int grid = 0;
    if (grid == 0) {
        if (n_in != 23 || ws_size < WS_END) { fprintf(stderr, "kernel_launch: unexpected n_in %d or workspace %zu < %zu\n", n_in, ws_size, (size_t)WS_END); grid = -1; return; }
        int dev = 0, cus = 0, per_cu = 0;
        hipGetDevice(&dev);
        hipDeviceGetAttribute(&cus, hipDeviceAttributeMultiprocessorCount, dev);
        if (hipFuncSetAttribute((const void*)fwd_kernel, hipFuncAttributeMaxDynamicSharedMemorySize, LDS_BYTES) != hipSuccess) { fprintf(stderr, "kernel_launch: hipFuncSetAttribute failed\n"); grid = -1; return; }
        hipOccupancyMaxActiveBlocksPerMultiprocessor(&per_cu, (const void*)fwd_kernel, NTHREADS, LDS_BYTES);
        if (per_cu < 1) per_cu = 1;
        grid = cus * per_cu;
        (void)hipGetLastError();
    }
    if (grid < 0) return;
    (void)hipMemsetAsync((char*)d_ws + WS_CTL, 0, 16384, stream);
    Params p{};
    const float** pp = (const float**)&p;
    for (int i = 0; i < 23; ++i) pp[i] = (const float*)d_in[i];
    p.out = (float*)d_out; p.ws = (unsigned char*)d_ws;
#if ONE_LAUNCH
    p.ph_lo = 0; p.ph_hi = N_PHASES; p.coop = 1;
    void* args[] = {&p};
    hipError_t e = hipLaunchCooperativeKernel((const void*)fwd_kernel, dim3(grid), dim3(NTHREADS), args, LDS_BYTES, stream);
    if (e != hipSuccess) fprintf(stderr, "cooperative launch failed: %s (grid %d)\n", hipGetErrorString(e), grid);
#else
    for (int ph = 0; ph < N_PHASES; ++ph) {
        p.ph_lo = ph; p.ph_hi = ph + 1; p.coop = 0;
        hipLaunchKernelGGL(fwd_kernel, dim3(grid), dim3(NTHREADS), LDS_BYTES, stream, p);
    }
#endif
}
```

```cpp
#include <hip/hip_runtime.h>
#include <hip/hip_cooperative_groups.h>
#include <cstdio>
#include <type_traits>
namespace cg = cooperative_groups;

#ifndef ONE_LAUNCH
#define ONE_LAUNCH 1
#endif

#define DI __device__ __forceinline__
#define LAS __attribute__((address_space(3)))
typedef unsigned short bf16_t;
typedef short bf16x8 __attribute__((ext_vector_type(8)));
typedef short s16x4 __attribute__((ext_vector_type(4)));
typedef float f32x4 __attribute__((ext_vector_type(4)));
typedef unsigned u32x4 __attribute__((ext_vector_type(4)));
typedef unsigned u32x2 __attribute__((ext_vector_type(2)));

constexpr int D = 1024, NB = 8, SEQ = 4096, CTXL = 256;
constexpr int TCTX = NB * CTXL;
constexpr int TLAT = NB * SEQ;
constexpr int T = TCTX + TLAT;
constexpr int DFF = 2816, NFF = 5632;
constexpr int PN = 3328;
constexpr int PLD = 3104;
constexpr int NMOD = 9 * D;
constexpr float EPS = 1e-6f;
constexpr int NTHREADS = 512;
constexpr int LDS_BYTES = 147456;

constexpr size_t WS_CTL = 0;
constexpr size_t WS_MODS = 16384;
constexpr size_t WS_GATES = WS_MODS + (size_t)2 * 9 * NMOD * 4;
constexpr size_t WS_XC = WS_GATES + (size_t)T * 16 * 4;
constexpr size_t WS_WFI = WS_XC + (size_t)TCTX * D * 4;
constexpr size_t SZ_WFI = (size_t)NFF * D * 2;
constexpr size_t WS_WFO = WS_WFI + 4 * SZ_WFI;
constexpr size_t SZ_WFO = (size_t)D * DFF * 2;
constexpr size_t WS_WMI = WS_WFO + 4 * SZ_WFO;
constexpr size_t SZ_WMI = (size_t)PN * D * 2;
constexpr size_t WS_WMO = WS_WMI + 2 * SZ_WMI;
constexpr size_t SZ_WMO = (size_t)D * D * 2;
constexpr size_t WS_HB = WS_WMO + 2 * SZ_WMO;
constexpr size_t WS_PH = WS_HB + (size_t)T * D * 2;
constexpr size_t WS_SC = WS_PH + (size_t)T * PLD * 2;
constexpr size_t WS_END = WS_SC + (size_t)T * D * 2 * 2;

struct Params {
    const float *x, *c, *ctx, *c_ctx, *ada_w, *ada_b, *norm_g, *ffn_w_in, *ffn_w_out, *even_w_in, *even_w_out, *diff_lambda, *diff_norm_g,
        *conv_w, *conv_b, *gate_b, *ml_norm_g, *odd_w_in, *odd_w_out, *gla_w_gate, *gla_b_gate, *gla_norm_g, *final_g;
    float* out;
    unsigned char* ws;
    int ph_lo, ph_hi, coop, pad;
};

DI int tid_op() { int t = threadIdx.x; asm volatile("" : "+v"(t)); return t; }
DI int bid_op() { int b = blockIdx.x; asm volatile("" : "+s"(b)); return b; }
DI bf16_t f2bf(float f) { unsigned u = __float_as_uint(f); u += 0x7fffu + ((u >> 16) & 1u); return (bf16_t)(u >> 16); }
DI float bf2f(bf16_t b) { return __uint_as_float(((unsigned)b) << 16); }
typedef __bf16 hbf2 __attribute__((ext_vector_type(2)));
typedef float f32x2 __attribute__((ext_vector_type(2)));
DI unsigned pack2(float lo, float hi) { const f32x2 v = {lo, hi}; const hbf2 r = __builtin_convertvector(v, hbf2); return __builtin_bit_cast(unsigned, r); }
DI float siluf(float a) { return a * __builtin_amdgcn_rcpf(1.f + __expf(-a)); }
DI float sigmoidf(float a) { return __builtin_amdgcn_rcpf(1.f + __expf(-a)); }
DI float logsigf(float x) { return fminf(x, 0.f) - __logf(1.f + __expf(-fabsf(x))); }
DI void lds_barrier() { asm volatile("s_waitcnt lgkmcnt(0)" ::: "memory"); __builtin_amdgcn_s_barrier(); asm volatile("" ::: "memory"); }
DI f32x4 mfma16(bf16x8 a, bf16x8 b, f32x4 c) { return __builtin_amdgcn_mfma_f32_16x16x32_bf16(a, b, c, 0, 0, 0); }
DI bf16x8 ldfrag(const bf16_t* base, int ld, int row, int k0) { return *(const bf16x8*)(base + row * ld + k0); }
DI float wave_sum(float v) { for (int o = 32; o > 0; o >>= 1) v += __shfl_xor(v, o); return v; }
DI float wave_max(float v) { for (int o = 32; o > 0; o >>= 1) v = fmaxf(v, __shfl_xor(v, o)); return v; }
DI const float* xrow_src(const float* sc, const float* sl, int row) { return row < TCTX ? sc + (size_t)row * D : sl + (size_t)(row - TCTX) * D; }
DI float* xrow_dst(float* sc, float* sl, int row) { return row < TCTX ? sc + (size_t)row * D : sl + (size_t)(row - TCTX) * D; }
DI int mod_row(int row) { return row < TCTX ? 8 : (row - TCTX) >> 12; }

namespace g8 {
constexpr int BM = 256, BK = 64, HALF = 128, HTB = HALF * BK * 2, NXCD = 8, WGM = 8;
DI int lds_byte(int r, int c) { const int st = (r >> 4) * 2 + (c >> 5), rr = r & 15, cc = c & 31, ob = rr * 64 + cc * 2; return st * 1024 + (ob ^ (((ob >> 9) & 1) << 5)); }
DI void stage_rc(int b, int& R, int& C) { const int st = b / 1024, sb = b % 1024, swz = sb ^ (((sb >> 9) & 1) << 5); R = (st >> 1) * 16 + swz / 64; C = (st & 1) * 32 + (swz % 64) / 2; }
DI int perm32(int rho) { const int n = rho >> 4, i = rho & 15; return 8 * (i >> 2) + 4 * n + (i & 3); }
struct Unit { int pm, pn; };
struct Gemm { const bf16_t* A; const bf16_t* Bt; int M, N, K, ld; };
struct SingleUnit { Unit u; DI bool next(int i, Unit& o) const { if (i != 0) return false; o = u; return true; } };
struct StaticOrder {
    int nM, nN, nwg, G, c;
    DI void init(int M, int N, int G_, int c_) { nM = M / BM; nN = N / BM; nwg = nM * nN; G = G_; c = c_; }
    DI bool next(int i, Unit& u) const {
        const long L = (long)i * G + c; if (L >= nwg) return false;
        int wgid = (int)L; { const int q = nwg / NXCD, r = nwg % NXCD, xcd = wgid % NXCD, off = wgid / NXCD; wgid = (xcd < r ? xcd * (q + 1) : r * (q + 1) + (xcd - r) * q) + off; }
        const int nig = WGM * nN, gid = wgid / nig, fm = gid * WGM, gsz = (nM - fm) < WGM ? (nM - fm) : WGM;
        u.pm = fm + ((wgid % nig) % gsz); u.pn = (wgid % nig) / gsz; return true;
    }
};

template <class Epi, class Sched>
DI void gemm_phase(LAS unsigned char* lds, const Gemm g, const Sched& S, const Epi& E) {
    const int tid = tid_op(), wid = __builtin_amdgcn_readfirstlane(tid >> 6), lane = tid & 63, wr = wid >> 2, wc = wid & 3, fr = lane & 15, fq = lane >> 4;
    const int K = g.K, nt = K / BK, LD = g.ld;
    unsigned voffA[2], voffB[2];
#pragma unroll
    for (int i = 0; i < 2; ++i) { int R, C; stage_rc(tid * 16 + i * 8192, R, C); const int Rb = Epi::PERM ? ((R & ~31) + perm32(R & 31)) : R;
        voffA[i] = (unsigned)(R * LD + C) * 2u; voffB[i] = (unsigned)(Rb * LD + C) * 2u; }
    const size_t kstep = (size_t)(BK * 2);
    const size_t hstep = (size_t)HALF * LD * 2;
    const size_t tstep = 2 * hstep;
    const unsigned ldsw = (unsigned)wid * 1024u;
    const int aoff = lds_byte(wr * 64 + fr, fq * 8), boff = lds_byte(wc * 32 + fr, fq * 8);
#define G8_SA(b, h) (((b) * 2 + (h)) * HTB)
#define G8_SB(b, h) ((4 + (b) * 2 + (h)) * HTB)
#define G8_STAGE(bufoff, gbase, voff) do { _Pragma("unroll") for (int _i = 0; _i < 2; ++_i) \
        __builtin_amdgcn_global_load_lds((const unsigned*)((const char*)(gbase) + (voff)[_i]), (LAS unsigned*)(lds + (bufoff) + ldsw + _i * 8192), 16, 0, 0); } while (0)
#define G8_LDA(dst, b, h) do { _Pragma("unroll") for (int m = 0; m < 4; ++m) _Pragma("unroll") for (int k = 0; k < 2; ++k) dst[m][k] = *(const LAS bf16x8*)(lds + G8_SA(b, h) + aoff + m * 2048 + k * 1024); } while (0)
#define G8_LDB(dst, b, h) do { _Pragma("unroll") for (int n = 0; n < 2; ++n) _Pragma("unroll") for (int k = 0; k < 2; ++k) dst[n][k] = *(const LAS bf16x8*)(lds + G8_SB(b, h) + boff + n * 2048 + k * 1024); } while (0)
#define G8_MMA(ai, bj, At, Bt) do { __builtin_amdgcn_s_setprio(1); _Pragma("unroll") for (int m = 0; m < 4; ++m) _Pragma("unroll") for (int n = 0; n < 2; ++n) _Pragma("unroll") for (int k = 0; k < 2; ++k) \
        acc[ai][bj][m][n] = __builtin_amdgcn_mfma_f32_16x16x32_bf16(Bt[n][k], At[m][k], acc[ai][bj][m][n], 0, 0, 0); __builtin_amdgcn_s_setprio(0); } while (0)
#define G8_WAIT_V(n) asm volatile("s_waitcnt vmcnt(" #n ")" ::: "memory")
#define G8_WAIT_L(n) asm volatile("s_waitcnt lgkmcnt(" #n ")" ::: "memory")
#define G8_BAR __builtin_amdgcn_s_barrier()
#define G8_SCHED __builtin_amdgcn_sched_barrier(0)
    Unit cur, nxt; int ui = 0;
    if (!S.next(0, cur)) return;
    f32x4 acc[2][2][4][2];
#pragma unroll
    for (int a = 0; a < 2; ++a)
#pragma unroll
        for (int b = 0; b < 2; ++b)
#pragma unroll
            for (int m = 0; m < 4; ++m)
#pragma unroll
                for (int n = 0; n < 2; ++n) acc[a][b][m][n] = (f32x4){0.f, 0.f, 0.f, 0.f};
    bf16x8 At[4][2], B0[2][2], B1[2][2];
    const char* cA = (const char*)g.A + (size_t)cur.pm * tstep; const char* cB = (const char*)g.Bt + (size_t)cur.pn * tstep;
    G8_STAGE(G8_SB(0, 0), cB, voffB); G8_STAGE(G8_SA(0, 0), cA, voffA); G8_STAGE(G8_SB(0, 1), cB + hstep, voffB); G8_STAGE(G8_SA(0, 1), cA + hstep, voffA);
    if (wr == 1) G8_BAR;
    G8_WAIT_V(4); G8_BAR;
    G8_STAGE(G8_SB(1, 0), cB + kstep, voffB); G8_STAGE(G8_SA(1, 0), cA + kstep, voffA); G8_STAGE(G8_SB(1, 1), cB + hstep + kstep, voffB);
    G8_WAIT_V(6); G8_BAR;
    for (;;) {
        const bool has_next = S.next(ui + 1, nxt);
        const char* nA = has_next ? (const char*)g.A + (size_t)nxt.pm * tstep : cA; const char* nB = has_next ? (const char*)g.Bt + (size_t)nxt.pn * tstep : cB;
        for (int t = 0; t < nt; t += 2) {
            const bool last = (t == nt - 2);
            const char* a1 = cA + (size_t)(t + 1) * kstep;
            const char* a2 = last ? nA : cA + (size_t)(t + 2) * kstep; const char* b2 = last ? nB : cB + (size_t)(t + 2) * kstep;
            const char* a3 = a2 + kstep; const char* b3 = b2 + kstep;
            G8_LDB(B0, 0, 0); G8_SCHED; G8_LDA(At, 0, 0); G8_STAGE(G8_SA(1, 1), a1 + hstep, voffA);
            G8_WAIT_L(8); G8_BAR; G8_WAIT_L(0); G8_MMA(0, 0, At, B0); G8_BAR; G8_SCHED;
            G8_LDB(B1, 0, 1); G8_STAGE(G8_SB(0, 0), b2, voffB);
            G8_BAR; G8_WAIT_L(0); G8_MMA(0, 1, At, B1); G8_BAR;
            G8_LDA(At, 0, 1); G8_STAGE(G8_SA(0, 0), a2, voffA);
            G8_BAR; G8_WAIT_L(0); G8_MMA(1, 0, At, B0); G8_BAR; G8_SCHED;
            G8_STAGE(G8_SB(0, 1), b2 + hstep, voffB);
            G8_WAIT_V(6); G8_BAR; G8_MMA(1, 1, At, B1); G8_BAR;
            G8_LDB(B0, 1, 0); G8_SCHED; G8_LDA(At, 1, 0); G8_STAGE(G8_SA(0, 1), a2 + hstep, voffA);
            G8_WAIT_L(8); G8_BAR; G8_WAIT_L(0); G8_MMA(0, 0, At, B0); G8_BAR; G8_SCHED;
            G8_LDB(B1, 1, 1); G8_STAGE(G8_SB(1, 0), b3, voffB);
            G8_BAR; G8_WAIT_L(0); G8_MMA(0, 1, At, B1); G8_BAR;
            G8_LDA(At, 1, 1); G8_STAGE(G8_SA(1, 0), a3, voffA);
            G8_BAR; G8_WAIT_L(0); G8_MMA(1, 0, At, B0); G8_BAR; G8_SCHED;
            G8_STAGE(G8_SB(1, 1), b3 + hstep, voffB);
            G8_WAIT_V(6); G8_BAR; G8_MMA(1, 1, At, B1); G8_BAR;
        }
        E(acc, cur, wr, wc, fr, fq);
        if (!has_next) break;
#pragma unroll
        for (int a = 0; a < 2; ++a)
#pragma unroll
            for (int b = 0; b < 2; ++b)
#pragma unroll
                for (int m = 0; m < 4; ++m)
#pragma unroll
                    for (int n = 0; n < 2; ++n) acc[a][b][m][n] = (f32x4){0.f, 0.f, 0.f, 0.f};
        cur = nxt; cA = nA; cB = nB; ++ui;
    }
    G8_WAIT_V(0);
    if (wr == 0) G8_BAR;
    G8_BAR;
#undef G8_SA
#undef G8_SB
#undef G8_STAGE
#undef G8_LDA
#undef G8_LDB
#undef G8_MMA
#undef G8_WAIT_V
#undef G8_WAIT_L
#undef G8_BAR
#undef G8_SCHED
}

struct EpiSwiglu {
    static constexpr bool PERM = true;
    bf16_t* H; int row_base;
    DI void operator()(const f32x4 (&acc)[2][2][4][2], const Unit& u, int wr, int wc, int fr, int fq) const {
        const int row0 = row_base + u.pm * BM + wr * 64 + fr, col0 = u.pn * 128 + wc * 32 + 8 * fq;
#pragma unroll
        for (int ai = 0; ai < 2; ++ai)
#pragma unroll
            for (int m = 0; m < 4; ++m) {
                bf16_t* rowp = H + (size_t)(row0 + ai * HALF + m * 16) * DFF + col0;
                const f32x4 a0 = acc[ai][0][m][0], a1 = acc[ai][0][m][1], b0 = acc[ai][1][m][0], b1 = acc[ai][1][m][1];
                u32x4 o;
                o[0] = pack2(siluf(a0[0]) * b0[0], siluf(a0[1]) * b0[1]); o[1] = pack2(siluf(a0[2]) * b0[2], siluf(a0[3]) * b0[3]);
                o[2] = pack2(siluf(a1[0]) * b1[0], siluf(a1[1]) * b1[1]); o[3] = pack2(siluf(a1[2]) * b1[2], siluf(a1[3]) * b1[3]);
                *(u32x4*)rowp = o;
            }
    }
};
struct EpiResid {
    static constexpr bool PERM = false;
    const float* src_ctx; const float* src_lat; float* dst_ctx; float* dst_lat; const float* mods; int gate_idx; float coef; int row_base;
    DI void operator()(const f32x4 (&acc)[2][2][4][2], const Unit& u, int wr, int wc, int fr, int fq) const {
        const int trow = row_base + u.pm * BM;
        const float* gate = mods + (size_t)mod_row(trow) * NMOD + gate_idx * D;
        const float* Sp = xrow_src(src_ctx, src_lat, trow); float* Dp = xrow_dst(dst_ctx, dst_lat, trow);
        const int r0 = wr * 64 + fr, col0 = u.pn * BM + wc * 32 + 4 * fq;
        auto& A = const_cast<f32x4 (&)[2][2][4][2]>(acc);
        {
            f32x4 gv[2][2];
            __builtin_amdgcn_sched_barrier(0);
#pragma unroll
            for (int bj = 0; bj < 2; ++bj)
#pragma unroll
                for (int n = 0; n < 2; ++n) gv[bj][n] = *(const f32x4*)(gate + col0 + bj * HALF + n * 16);
            __builtin_amdgcn_sched_barrier(0);
#pragma unroll
            for (int bj = 0; bj < 2; ++bj)
#pragma unroll
                for (int n = 0; n < 2; ++n) {
                    const f32x4 gvv = gv[bj][n] * coef;
#pragma unroll
                    for (int ai = 0; ai < 2; ++ai)
#pragma unroll
                        for (int m = 0; m < 4; ++m) { A[ai][bj][m][n] *= gvv; asm volatile("" : "+v"(A[ai][bj][m][n])); }
                }
        }
        auto batch = [&](auto MM, int ai, int m0) {
            constexpr int NM = decltype(MM)::value;
            f32x4 xv[NM][2][2];
            __builtin_amdgcn_sched_barrier(0);
#pragma unroll
            for (int mm = 0; mm < NM; ++mm)
#pragma unroll
                for (int bj = 0; bj < 2; ++bj)
#pragma unroll
                    for (int n = 0; n < 2; ++n) xv[mm][bj][n] = *(const f32x4*)(Sp + (size_t)(r0 + ai * HALF + (m0 + mm) * 16) * D + col0 + bj * HALF + n * 16);
            __builtin_amdgcn_sched_barrier(0);
            asm volatile("s_waitcnt vmcnt(0)" ::: "memory");
            __builtin_amdgcn_sched_barrier(0);
#pragma unroll
            for (int mm = 0; mm < NM; ++mm)
#pragma unroll
                for (int bj = 0; bj < 2; ++bj)
#pragma unroll
                    for (int n = 0; n < 2; ++n) *(f32x4*)(Dp + (size_t)(r0 + ai * HALF + (m0 + mm) * 16) * D + col0 + bj * HALF + n * 16) = xv[mm][bj][n] + A[ai][bj][m0 + mm][n];
            asm volatile("" ::: "memory");
        };
        __builtin_amdgcn_sched_barrier(0);
        batch(std::integral_constant<int, 2>{}, 0, 0); batch(std::integral_constant<int, 2>{}, 0, 2);
        batch(std::integral_constant<int, 2>{}, 1, 0); batch(std::integral_constant<int, 2>{}, 1, 2);
    }
};
struct EpiPartial {
    static constexpr bool PERM = false;
    bf16_t* slab; const float* gate; float coef;
    DI void operator()(const f32x4 (&acc)[2][2][4][2], const Unit& u, int wr, int wc, int fr, int fq) const {
        const int r0 = u.pm * BM + wr * 64 + fr, col0 = u.pn * BM + wc * 32 + 4 * fq;
#pragma unroll
        for (int bj = 0; bj < 2; ++bj)
#pragma unroll
            for (int n = 0; n < 2; ++n) {
                const f32x4 gv = *(const f32x4*)(gate + col0 + bj * HALF + n * 16) * coef;
#pragma unroll
                for (int ai = 0; ai < 2; ++ai)
#pragma unroll
                    for (int m = 0; m < 4; ++m) {
                        const f32x4 v = gv * acc[ai][bj][m][n];
                        u32x2 o; o[0] = pack2(v[0], v[1]); o[1] = pack2(v[2], v[3]);
                        *(u32x2*)(slab + (size_t)(r0 + ai * HALF + m * 16) * D + col0 + bj * HALF + n * 16) = o;
                    }
            }
    }
};
struct EpiP {
    static constexpr bool PERM = true;
    bf16_t* P; float* gates; const float* gate_b;
    DI void operator()(const f32x4 (&acc)[2][2][4][2], const Unit& u, int wr, int wc, int fr, int fq) const {
        const int row0 = u.pm * BM + wr * 64 + fr;
#pragma unroll
        for (int bj = 0; bj < 2; ++bj) {
            const int col0 = u.pn * BM + bj * HALF + wc * 32 + 8 * fq;
            if (col0 >= PLD) continue;
            const bool isg = gates != nullptr && col0 >= 3072 && col0 < 3088;
#pragma unroll
            for (int ai = 0; ai < 2; ++ai)
#pragma unroll
                for (int m = 0; m < 4; ++m) {
                    const int row = row0 + ai * HALF + m * 16;
                    const f32x4 v0 = acc[ai][bj][m][0], v1 = acc[ai][bj][m][1];
                    u32x4 o; o[0] = pack2(v0[0], v0[1]); o[1] = pack2(v0[2], v0[3]); o[2] = pack2(v1[0], v1[1]); o[3] = pack2(v1[2], v1[3]);
                    *(u32x4*)(P + (size_t)row * PLD + col0) = o;
                    if (isg) {
                        const int gc = col0 - 3072;
                        float* gp = gates + (size_t)row * 16 + gc;
                        const f32x4 b0 = *(const f32x4*)(gate_b + gc), b1 = *(const f32x4*)(gate_b + gc + 4);
                        *(f32x4*)gp = v0 + b0; *(f32x4*)(gp + 4) = v1 + b1;
                    }
                }
        }
    }
};
}

struct TrJob { const float* src; bf16_t* dst; int K, Nsrc, Nvalid, mode, tk, tn; };
DI void tr_load(const TrJob& j, f32x4 (&r)[8]) {
    const int tid = tid_op(), n = j.tn * 256 + (tid & 63) * 4, k0 = j.tk * 64;
    const int sc = j.mode == 1 ? ((n >> 7) & 1) * DFF + (n >> 8) * 128 + (n & 127) : n;
#pragma unroll
    for (int it = 0; it < 8; ++it) { const int kk = it * 8 + (tid >> 6); r[it] = (n < j.Nvalid) ? *(const f32x4*)(j.src + (size_t)(k0 + kk) * j.Nsrc + sc) : (f32x4){0.f, 0.f, 0.f, 0.f}; }
}
DI void tr_store(const TrJob& j, const f32x4 (&r)[8], float* tile) {
    const int tid = tid_op(), n0 = j.tn * 256, k0 = j.tk * 64;
#pragma unroll
    for (int it = 0; it < 8; ++it) {
        float* tp = tile + (it * 8 + (tid >> 6)) * 257 + (tid & 63) * 4;
        tp[0] = r[it][0]; tp[1] = r[it][1]; tp[2] = r[it][2]; tp[3] = r[it][3];
    }
    __syncthreads();
    {
        const int g = tid & 7;
#pragma unroll
        for (int it = 0; it < 4; ++it) {
            const int rr = it * 64 + (tid >> 3);
            const float* tp = tile + (8 * g) * 257 + rr;
            u32x4 o;
            o[0] = pack2(tp[0], tp[257]); o[1] = pack2(tp[2 * 257], tp[3 * 257]); o[2] = pack2(tp[4 * 257], tp[5 * 257]); o[3] = pack2(tp[6 * 257], tp[7 * 257]);
            *(u32x4*)(j.dst + (size_t)(n0 + rr) * j.K + k0 + 8 * g) = o;
        }
    }
    __syncthreads();
}

DI void phase_prep(const Params& p, unsigned char* smem) {
    const int tid = tid_op(), bid = bid_op(), nblk = gridDim.x;
    { const f32x4* src = (const f32x4*)p.ctx; f32x4* dst = (f32x4*)(p.ws + WS_XC);
      for (int i = bid * NTHREADS + tid; i < TCTX * D / 4; i += nblk * NTHREADS) dst[i] = src[i]; }
    float* tile = (float*)smem;
    constexpr int N_FI = 16 * 22, N_FO = 44 * 4, N_MI = 16 * 13, N_MO = 16 * 4;
    constexpr int E_FI = 4 * N_FI, E_FO = E_FI + 4 * N_FO, E_MI = E_FO + 2 * N_MI, E_MO = E_MI + 2 * N_MO;
    auto decode = [&](int it) -> TrJob {
        TrJob j;
        if (it < E_FI) { const int q = it / N_FI, t = it % N_FI; j = TrJob{p.ffn_w_in + (size_t)q * D * NFF, (bf16_t*)(p.ws + WS_WFI + q * SZ_WFI), D, NFF, NFF, 1, t % 16, t / 16}; }
        else if (it < E_FO) { const int i2 = it - E_FI, q = i2 / N_FO, t = i2 % N_FO; j = TrJob{p.ffn_w_out + (size_t)q * DFF * D, (bf16_t*)(p.ws + WS_WFO + q * SZ_WFO), DFF, D, D, 0, t % 44, t / 44}; }
        else if (it < E_MI) { const int i2 = it - E_FO, q = i2 / N_MI, t = i2 % N_MI; j = TrJob{q == 0 ? p.even_w_in : p.odd_w_in, (bf16_t*)(p.ws + WS_WMI + q * SZ_WMI), D, q == 0 ? 3088 : 3104, q == 0 ? 3088 : 3104, 0, t % 16, t / 16}; }
        else { const int i2 = it - E_MI, q = i2 / N_MO, t = i2 % N_MO; j = TrJob{q == 0 ? p.even_w_out : p.odd_w_out, (bf16_t*)(p.ws + WS_WMO + q * SZ_WMO), D, D, D, 0, t % 16, t / 16}; }
        return j;
    };
    {
        f32x4 r0[8], r1[8], r2[8];
        int it = bid;
        if (it < E_MO) { TrJob j = decode(it); tr_load(j, r0); }
        if (it + nblk < E_MO) { TrJob j = decode(it + nblk); tr_load(j, r1); }
        for (;;) {
            if (it >= E_MO) break;
            if (it + 2 * nblk < E_MO) { TrJob jn = decode(it + 2 * nblk); tr_load(jn, r2); }
            { TrJob j = decode(it); tr_store(j, r0, tile); } it += nblk;
            if (it >= E_MO) break;
            if (it + 2 * nblk < E_MO) { TrJob jn = decode(it + 2 * nblk); tr_load(jn, r0); }
            { TrJob j = decode(it); tr_store(j, r1, tile); } it += nblk;
            if (it >= E_MO) break;
            if (it + 2 * nblk < E_MO) { TrJob jn = decode(it + 2 * nblk); tr_load(jn, r1); }
            { TrJob j = decode(it); tr_store(j, r2, tile); } it += nblk;
        }
    }
    float* sv = (float*)smem;
    f32x4* red = (f32x4*)(smem + 9 * D * 4);
    bool staged = false;
    for (int ch = bid; ch < 256; ch += nblk) {
        if (!staged) {
            __syncthreads();
            for (int i = tid; i < 9 * D; i += NTHREADS) { const float v = i < 8 * D ? p.c[i] : p.c_ctx[i - 8 * D]; sv[i] = siluf(v); }
            __syncthreads(); staged = true;
        }
        const int l = ch >> 7, j0 = (ch & 127) * 72, cg = tid % 18, kg = tid / 18;
        if (kg < 28) {
            f32x4 a[9];
#pragma unroll
            for (int r = 0; r < 9; ++r) a[r] = (f32x4){0.f, 0.f, 0.f, 0.f};
            const float* w = p.ada_w + (size_t)l * D * NMOD + j0 + 4 * cg;
            const int k1 = (kg + 1) * 37 < D ? (kg + 1) * 37 : D;
#pragma unroll 4
            for (int k = kg * 37; k < k1; ++k) {
                const f32x4 wv = *(const f32x4*)(w + (size_t)k * NMOD);
#pragma unroll
                for (int r = 0; r < 9; ++r) a[r] += wv * sv[r * D + k];
            }
#pragma unroll
            for (int r = 0; r < 9; ++r) red[(kg * 9 + r) * 18 + cg] = a[r];
        }
        __syncthreads();
        if (tid < 162) {
            const int r = tid / 18, cc = tid % 18; f32x4 sacc = (f32x4){0.f, 0.f, 0.f, 0.f};
            for (int g = 0; g < 28; ++g) sacc += red[(g * 9 + r) * 18 + cc];
            *(f32x4*)((float*)(p.ws + WS_MODS) + ((size_t)l * 9 + r) * NMOD + j0 + 4 * cc) = sacc + *(const f32x4*)(p.ada_b + (size_t)l * NMOD + j0 + 4 * cc);
        }
        __syncthreads();
    }
}

DI void phase_norm(const float* src_ctx, const float* src_lat, bf16_t* HB, const float* mods_l, const float* g, int kshift, int row_lo, const bf16_t* slab, int nsl, float* xc_out) {
    const int tid = tid_op(); const int lane = tid & 63, gw = bid_op() * 8 + (tid >> 6), nw = gridDim.x * 8;
    for (int row = row_lo + gw; row < T; row += nw) {
        const float* xr = xrow_src(src_ctx, src_lat, row);
        const float* md = mods_l + (size_t)mod_row(row) * NMOD;
        f32x4 v[4]; float ss = 0.f;
#pragma unroll
        for (int i = 0; i < 4; ++i) {
            v[i] = *(const f32x4*)(xr + i * 256 + lane * 4);
            if (slab != nullptr && row < TCTX) {
                for (int sl = 0; sl < nsl; ++sl) { const u32x2 q = *(const u32x2*)(slab + ((size_t)sl * TCTX + row) * D + i * 256 + lane * 4);
                    v[i][0] += bf2f((bf16_t)(q[0] & 0xffffu)); v[i][1] += bf2f((bf16_t)(q[0] >> 16)); v[i][2] += bf2f((bf16_t)(q[1] & 0xffffu)); v[i][3] += bf2f((bf16_t)(q[1] >> 16)); }
                *(f32x4*)(xc_out + (size_t)row * D + i * 256 + lane * 4) = v[i];
            }
            ss += v[i][0] * v[i][0] + v[i][1] * v[i][1] + v[i][2] * v[i][2] + v[i][3] * v[i][3];
        }
        ss = wave_sum(ss);
        const float rstd = rsqrtf(ss * (1.f / D) + EPS);
#pragma unroll
        for (int i = 0; i < 4; ++i) {
            const int cidx = i * 256 + lane * 4;
            const f32x4 gg = *(const f32x4*)(g + cidx), sh = *(const f32x4*)(md + kshift * D + cidx), sc = *(const f32x4*)(md + (kshift + 1) * D + cidx);
            const f32x4 h = v[i] * rstd * gg * (sc + 1.f) + sh;
            u32x2 o; o[0] = pack2(h[0], h[1]); o[1] = pack2(h[2], h[3]);
            *(u32x2*)(HB + (size_t)row * D + cidx) = o;
        }
    }
}

DI void phase_final(float* X, const float* g) {
    const int tid = tid_op(); const int lane = tid & 63, gw = bid_op() * 8 + (tid >> 6), nw = gridDim.x * 8;
    f32x4 gg[4];
#pragma unroll
    for (int i = 0; i < 4; ++i) gg[i] = *(const f32x4*)(g + i * 256 + lane * 4);
    for (int row = gw; row < TLAT; row += 2 * nw) {
        const int row1 = row + nw < TLAT ? row + nw : row;
        f32x4 v[2][4];
#pragma unroll
        for (int i = 0; i < 4; ++i) { v[0][i] = *(const f32x4*)(X + (size_t)row * D + i * 256 + lane * 4); v[1][i] = *(const f32x4*)(X + (size_t)row1 * D + i * 256 + lane * 4); }
        asm volatile("" ::: "memory");
#pragma unroll
        for (int r = 0; r < 2; ++r) {
            if (r == 1 && row1 == row) break;
            float ss = 0.f;
#pragma unroll
            for (int i = 0; i < 4; ++i) ss += v[r][i][0] * v[r][i][0] + v[r][i][1] * v[r][i][1] + v[r][i][2] * v[r][i][2] + v[r][i][3] * v[r][i][3];
            ss = wave_sum(ss);
            const float rstd = rsqrtf(ss * (1.f / D) + EPS);
            float* xr = X + (size_t)(r == 0 ? row : row1) * D;
#pragma unroll
            for (int i = 0; i < 4; ++i) *(f32x4*)(xr + i * 256 + lane * 4) = v[r][i] * rstd * gg[i];
        }
    }
}

DI void phase_e0(const Params& p, unsigned char* smem) {
    const int tid = tid_op();
    bf16_t* P = (bf16_t*)(p.ws + WS_PH);
    bf16_t* QKC = (bf16_t*)(p.ws + WS_SC);
    float* tab = (float*)smem;
    for (int i = tid; i < 1024; i += NTHREADS) {
        const int pos = i >> 4, f = i & 15;
        const float inv = powf(10000.0f, -(float)f * (2.0f / 32.0f));
        const float ang = (float)pos * inv;
        float s, c; sincosf(ang, &s, &c);
        tab[2 * i] = c; tab[2 * i + 1] = s;
    }
    __syncthreads();
    const int rsub = tid >> 6, t64 = tid & 63;
    const int ch0 = t64 * 8;
    float w0[8], w1[8], w2[8], cb[8];
#pragma unroll
    for (int j = 0; j < 8; ++j) { w0[j] = p.conv_w[ch0 + j]; w1[j] = p.conv_w[512 + ch0 + j]; w2[j] = p.conv_w[1024 + ch0 + j]; cb[j] = p.conv_b[ch0 + j]; }
    const float qs = ch0 < 256 ? 0.125f : 1.0f;
    const int grp = t64 >> 1, half = t64 & 1;
    const int cA = grp * 32 + half * 8;
    const int which = grp >> 4, axis = grp & 1;
    const float sc = which == 0 ? 0.18033688011112042f : 1.0f;
    for (int chunk = bid_op(); chunk < T / 16; chunk += gridDim.x) {
        const int row0 = chunk * 16;
        const bool isctx = row0 < TCTX;
        const int seq0 = isctx ? (row0 & 255) : ((row0 - TCTX) & 4095);
        const int seqlen = isctx ? CTXL : SEQ;
        u32x4 xm[2], x0[2], xp[2], ra[2], rb[2];
#pragma unroll
        for (int hh = 0; hh < 2; ++hh) {
            const int i = rsub + 8 * hh, row = row0 + i, t = seq0 + i;
            const bf16_t* src = P + (size_t)row * PLD + 1536 + ch0;
            xm[hh] = *(const u32x4*)(src - (t > 0 ? PLD : 0));
            x0[hh] = *(const u32x4*)src;
            xp[hh] = *(const u32x4*)(src + (t + 1 < seqlen ? PLD : 0));
            const bf16_t* r = P + (size_t)row * PLD + cA;
            ra[hh] = *(const u32x4*)r; rb[hh] = *(const u32x4*)(r + 16);
        }
        asm volatile("" ::: "memory");
#pragma unroll
        for (int hh = 0; hh < 2; ++hh) {
            const int i = rsub + 8 * hh, row = row0 + i, t = seq0 + i;
            {
                const bool hm = t > 0, hp = t + 1 < seqlen;
                u32x4 o;
#pragma unroll
                for (int j = 0; j < 4; ++j) {
                    const unsigned m_ = hm ? xm[hh][j] : 0u, p_ = hp ? xp[hh][j] : 0u, c_ = x0[hh][j];
                    const float y0 = w0[2 * j] * bf2f((bf16_t)(m_ & 0xffffu)) + w1[2 * j] * bf2f((bf16_t)(c_ & 0xffffu)) + w2[2 * j] * bf2f((bf16_t)(p_ & 0xffffu)) + cb[2 * j];
                    const float y1 = w0[2 * j + 1] * bf2f((bf16_t)(m_ >> 16)) + w1[2 * j + 1] * bf2f((bf16_t)(c_ >> 16)) + w2[2 * j + 1] * bf2f((bf16_t)(p_ >> 16)) + cb[2 * j + 1];
                    o[j] = pack2(siluf(y0) * qs, siluf(y1) * qs);
                }
                *(u32x4*)(QKC + (size_t)row * 512 + ch0) = o;
            }
            if (!isctx || which == 0) {
                bf16_t* r = P + (size_t)row * PLD + cA;
                const u32x4 a = ra[hh], b = rb[hh];
                const int pos = axis == 0 ? (t >> 6) : (t & 63);
                u32x4 oa, ob;
#pragma unroll
                for (int j = 0; j < 4; ++j) {
                    float a0 = bf2f((bf16_t)(a[j] & 0xffffu)), a1 = bf2f((bf16_t)(a[j] >> 16)), b0 = bf2f((bf16_t)(b[j] & 0xffffu)), b1 = bf2f((bf16_t)(b[j] >> 16));
                    if (!isctx) {
                        const int f0 = half * 8 + 2 * j;
                        const float c0 = tab[2 * (pos * 16 + f0)], s0 = tab[2 * (pos * 16 + f0) + 1], c1 = tab[2 * (pos * 16 + f0 + 1)], s1 = tab[2 * (pos * 16 + f0 + 1) + 1];
                        const float na0 = a0 * c0 - b0 * s0, nb0 = b0 * c0 + a0 * s0, na1 = a1 * c1 - b1 * s1, nb1 = b1 * c1 + a1 * s1;
                        a0 = na0; b0 = nb0; a1 = na1; b1 = nb1;
                    }
                    oa[j] = pack2(a0 * sc, a1 * sc); ob[j] = pack2(b0 * sc, b1 * sc);
                }
                *(u32x4*)r = oa; *(u32x4*)(r + 16) = ob;
            }
        }
    }
}

DI void attn_item(const Params& p, int item, unsigned char* smem, float lam) {
    const int tid = tid_op(), wid = tid >> 6, lane = tid & 63, fr = lane & 15, fq = lane >> 4;
    const bf16_t* P = (const bf16_t*)(p.ws + WS_PH);
    bf16_t* HB = (bf16_t*)(p.ws + WS_HB);
    constexpr int KLD = 136, VLD = 144, BUF = 64 * KLD + 64 * VLD;
    bf16_t* L0 = (bf16_t*)smem;
    int b, h, qrow0, nkt; bool isctx = item >= 1024;
    if (!isctx) { b = item >> 7; h = (item >> 5) & 3; const int qb = item & 31; qrow0 = TCTX + b * SEQ + qb * 128; nkt = 68; }
    else { const int it = item - 1024; b = it >> 3; h = (it >> 1) & 3; const int qb = it & 1; qrow0 = b * CTXL + qb * 128; nkt = 4; }
    const int qrow = qrow0 + wid * 16 + fr;
    bf16x8 Qf[2][2];
#pragma unroll
    for (int c = 0; c < 2; ++c)
#pragma unroll
        for (int ks = 0; ks < 2; ++ks) Qf[c][ks] = *(const bf16x8*)(P + (size_t)qrow * PLD + h * 128 + c * 64 + ks * 32 + 8 * fq);
    f32x4 O[2][8];
#pragma unroll
    for (int c = 0; c < 2; ++c)
#pragma unroll
        for (int e = 0; e < 8; ++e) O[c][e] = (f32x4){0.f, 0.f, 0.f, 0.f};
    float mrun[2] = {-1e30f, -1e30f};
    f32x4 Lacc[2] = {(f32x4){0.f, 0.f, 0.f, 0.f}, (f32x4){0.f, 0.f, 0.f, 0.f}};
    const bf16x8 ones = (bf16x8){0x3F80, 0x3F80, 0x3F80, 0x3F80, 0x3F80, 0x3F80, 0x3F80, 0x3F80};
    const int skey[2] = {tid >> 4, (tid >> 4) + 32}; const int sc8 = (tid & 15) * 8;
    u32x4 kreg[2], vreg[2];
    auto krow = [&](int kt, int key) -> size_t { return (size_t)(kt < 4 ? b * CTXL + kt * 64 + key : TCTX + b * SEQ + (kt - 4) * 64 + key); };
    auto prefetch = [&](int kt) {
#pragma unroll
        for (int i = 0; i < 2; ++i) {
            const bf16_t* rp = P + krow(kt, skey[i]) * PLD + h * 128 + sc8;
            kreg[i] = *(const u32x4*)(rp + 512);
            vreg[i] = *(const u32x4*)(rp + 1024);
        }
    };
    auto stage = [&](int buf) {
        bf16_t* Kb = L0 + buf * BUF; bf16_t* Vb = Kb + 64 * KLD;
#pragma unroll
        for (int i = 0; i < 2; ++i) { *(u32x4*)(Kb + skey[i] * KLD + sc8) = kreg[i]; *(u32x4*)(Vb + skey[i] * VLD + sc8) = vreg[i]; }
    };
    prefetch(0); stage(0);
    if (nkt > 1) prefetch(1);
    lds_barrier();
    for (int kt = 0; kt < nkt; ++kt) {
        if (kt + 1 < nkt) stage((kt + 1) & 1);
        if (kt + 2 < nkt) prefetch(kt + 2);
        const bf16_t* Ks = L0 + (kt & 1) * BUF; const bf16_t* Vs = Ks + 64 * KLD;
        bf16x8 pf[2][2];
#pragma unroll
        for (int c = 0; c < 2; ++c) {
            f32x4 s[4];
#pragma unroll
            for (int sub = 0; sub < 4; ++sub) {
                s[sub] = (f32x4){0.f, 0.f, 0.f, 0.f};
#pragma unroll
                for (int ks = 0; ks < 2; ++ks) s[sub] = mfma16(ldfrag(Ks, KLD, sub * 16 + fr, c * 64 + ks * 32 + 8 * fq), Qf[c][ks], s[sub]);
            }
            float mx = fmaxf(fmaxf(s[0][0], s[0][1]), fmaxf(s[0][2], s[0][3]));
#pragma unroll
            for (int sub = 1; sub < 4; ++sub) mx = fmaxf(mx, fmaxf(fmaxf(s[sub][0], s[sub][1]), fmaxf(s[sub][2], s[sub][3])));
            mx = fmaxf(mx, __shfl_xor(mx, 16)); mx = fmaxf(mx, __shfl_xor(mx, 32));
            if (__builtin_amdgcn_ballot_w64(mx > mrun[c] + 8.0f) != 0ull) {
                const float mnew = fmaxf(mrun[c], mx), alpha = __builtin_amdgcn_exp2f(mrun[c] - mnew);
                mrun[c] = mnew; Lacc[c] *= alpha;
#pragma unroll
                for (int e = 0; e < 8; ++e) O[c][e] *= alpha;
            }
            const float mref = mrun[c];
#pragma unroll
            for (int sub = 0; sub < 4; ++sub)
#pragma unroll
                for (int j = 0; j < 4; ++j) s[sub][j] = __builtin_amdgcn_exp2f(s[sub][j] - mref);
#pragma unroll
            for (int s2 = 0; s2 < 2; ++s2) {
                u32x4 pk;
                pk[0] = pack2(s[2 * s2][0], s[2 * s2][1]); pk[1] = pack2(s[2 * s2][2], s[2 * s2][3]);
                pk[2] = pack2(s[2 * s2 + 1][0], s[2 * s2 + 1][1]); pk[3] = pack2(s[2 * s2 + 1][2], s[2 * s2 + 1][3]);
                pf[c][s2] = __builtin_bit_cast(bf16x8, pk);
            }
        }
        const int voff = (4 * fq + (fr >> 2)) * VLD + 4 * (fr & 3);
#pragma unroll
        for (int e = 0; e < 8; ++e)
#pragma unroll
            for (int s2 = 0; s2 < 2; ++s2) {
                const s16x4 lo = __builtin_amdgcn_ds_read_tr16_b64_v4i16((LAS s16x4*)(LAS unsigned char*)(unsigned char*)(Vs + voff + (32 * s2) * VLD + 16 * e));
                const s16x4 hi = __builtin_amdgcn_ds_read_tr16_b64_v4i16((LAS s16x4*)(LAS unsigned char*)(unsigned char*)(Vs + voff + (32 * s2 + 16) * VLD + 16 * e));
                const bf16x8 vf = __builtin_shufflevector(lo, hi, 0, 1, 2, 3, 4, 5, 6, 7);
                O[0][e] = mfma16(vf, pf[0][s2], O[0][e]);
                O[1][e] = mfma16(vf, pf[1][s2], O[1][e]);
            }
#pragma unroll
        for (int s2 = 0; s2 < 2; ++s2) { Lacc[0] = mfma16(ones, pf[0][s2], Lacc[0]); Lacc[1] = mfma16(ones, pf[1][s2], Lacc[1]); }
        lds_barrier();
    }
    const float i0 = 1.f / Lacc[0][0], i1 = lam / Lacc[1][0];
    float ss = 0.f;
#pragma unroll
    for (int e = 0; e < 8; ++e)
#pragma unroll
        for (int j = 0; j < 4; ++j) { const float v = O[0][e][j] * i0 - O[1][e][j] * i1; O[0][e][j] = v; ss += v * v; }
    ss += __shfl_xor(ss, 16); ss += __shfl_xor(ss, 32);
    const float rstd = rsqrtf(ss * (1.f / 128.f) + EPS) * 0.8f;
#pragma unroll
    for (int e = 0; e < 8; ++e) {
        const f32x4 g = *(const f32x4*)(p.diff_norm_g + e * 16 + 4 * fq);
        u32x2 o; o[0] = pack2(O[0][e][0] * rstd * g[0], O[0][e][1] * rstd * g[1]); o[1] = pack2(O[0][e][2] * rstd * g[2], O[0][e][3] * rstd * g[3]);
        *(u32x2*)(HB + (size_t)qrow * D + h * 128 + e * 16 + 4 * fq) = o;
    }
}

DI void mlstm_scan(const Params& p, int sb, unsigned char* smem) {
    const int tid = tid_op(), wid = tid >> 6, lane = tid & 63, fr = lane & 15, fq = lane >> 4;
    const int b = sb >> 3, h = (sb >> 1) & 3, dir = sb & 1;
    const bf16_t* P = (const bf16_t*)(p.ws + WS_PH);
    const bf16_t* QKC = (const bf16_t*)(p.ws + WS_SC);
    bf16_t* MO = (bf16_t*)(p.ws + WS_SC) + (size_t)(1 + dir) * T * 512;
    const float* GT = (const float*)(p.ws + WS_GATES);
    bf16_t* Qs = (bf16_t*)smem; bf16_t* Ks = Qs + 64 * 72; bf16_t* KwT = Ks + 64 * 72; bf16_t* VT = KwT + 64 * 72  ; bf16_t* Sw = VT + 64 * 136; bf16_t* Cb = Sw + 64 * 72;
    float* fa = (float*)(Cb + 2 * 128 * 72);
    float* s_bc = fa; float* s_ic = fa + 64; float* s_mt = fa + 128; float* s_wi = fa + 192; float* s_wk = fa + 256; float* s_nv = fa + 320; float* s_qn = fa + 384; float* s_rsp = fa + 448;   float* s_sc = fa + 704;
    for (int i = tid; i < 2 * 128 * 72; i += NTHREADS) Cb[i] = 0;
    if (tid < 64) s_nv[tid] = 0.f;
    f32x4 Cacc[4] = {(f32x4){0.f, 0.f, 0.f, 0.f}, (f32x4){0.f, 0.f, 0.f, 0.f}, (f32x4){0.f, 0.f, 0.f, 0.f}, (f32x4){0.f, 0.f, 0.f, 0.f}};
    float mstate = 0.f;
    const int tr = wid >> 1, tc0 = (wid & 1) * 2;
    auto chunk_row0 = [&](int ci) -> int { return ci < 4 ? b * CTXL + (dir ? 3 - ci : ci) * 64 : TCTX + b * SEQ + (dir ? 63 - (ci - 4) : ci - 4) * 64; };
    auto pos_row = [&](int r0, int i) -> int { return r0 + (dir ? 63 - i : i); };
    u32x4 qreg, kreg, vreg[2]; float gi = 0.f, gf = 0.f;
    const int vrow[2] = {tid >> 4, (tid >> 4) + 32}; const int vcol = (tid & 15) * 8;
    const int qi = tid >> 3, qc8 = (tid & 7) * 8;
    auto prefetch = [&](int ci) {
        const int r0 = chunk_row0(ci);
        qreg = *(const u32x4*)(QKC + (size_t)pos_row(r0, qi) * 512 + h * 64 + qc8);
        kreg = *(const u32x4*)(QKC + (size_t)pos_row(r0, qi) * 512 + 256 + h * 64 + qc8);
        vreg[0] = *(const u32x4*)(P + (size_t)pos_row(r0, vrow[0]) * PLD + 2048 + h * 128 + vcol); vreg[1] = *(const u32x4*)(P + (size_t)pos_row(r0, vrow[1]) * PLD + 2048 + h * 128 + vcol);
        if (tid < 64) { const float* g = GT + (size_t)pos_row(r0, tid) * 16; gi = g[dir * 4 + h]; gf = g[(2 + dir) * 4 + h]; }
    };
    prefetch(0);
    int cur = 0;
    for (int ci = 0; ci < 68; ++ci) {
        const int r0 = chunk_row0(ci);
        lds_barrier();
        *(u32x4*)(Qs + qi * 72 + qc8) = qreg;
        *(u32x4*)(Ks + qi * 72 + qc8) = kreg;
        *(u32x4*)(VT + vrow[0] * 136 + vcol) = vreg[0]; *(u32x4*)(VT + vrow[1] * 136 + vcol) = vreg[1];
        if (wid == 0) {
            const float f = logsigf(gf);
            float bc = f;
            for (int o = 1; o < 64; o <<= 1) { const float t = __shfl_up(bc, o); if (lane >= o) bc += t; }
            const float bl = __shfl(bc, 63);
            float pm = gi - bc;
            for (int o = 1; o < 64; o <<= 1) { const float t = __shfl_up(pm, o); if (lane >= o) pm = fmaxf(pm, t); }
            const float mt = bc + fmaxf(mstate, pm);
            const float wi = __expf(bc + mstate - mt);
            const float g = bl - bc + gi;
            const float gmax = wave_max(g);
            const float mnew = fmaxf(bl + mstate, gmax);
            const float wk = __expf(g - mnew);
            const float decay = __expf(bl + mstate - mnew);
            s_bc[lane] = bc; s_ic[lane] = gi; s_mt[lane] = mt; s_wi[lane] = wi; s_wk[lane] = wk;
            if (lane == 0) s_sc[0] = decay;
            mstate = mnew;
        }
        lds_barrier();
        if (ci + 1 < 68) prefetch(ci + 1);
        {
            const int s = tid & 63, d8 = (tid >> 6) * 8; const float wk = s_wk[s];
            const int sslot = 32 * (s >> 5) + 8 * ((s >> 2) & 3) + 4 * ((s >> 4) & 1) + (s & 3);
            const u32x4 kv = *(const u32x4*)(Ks + s * 72 + d8);
#pragma unroll
            for (int j = 0; j < 4; ++j) { KwT[(d8 + 2 * j) * 72 + sslot] = f2bf(bf2f((bf16_t)(kv[j] & 0xffffu)) * wk); KwT[(d8 + 2 * j + 1) * 72 + sslot] = f2bf(bf2f((bf16_t)(kv[j] >> 16)) * wk); }
        }
        {
            const int t = tid >> 3, part = tid & 7; float a = 0.f;
#pragma unroll
            for (int j = 0; j < 8; ++j) a += bf2f(Qs[t * 72 + part * 8 + j]) * s_nv[part * 8 + j];
            a += __shfl_xor(a, 1); a += __shfl_xor(a, 2); a += __shfl_xor(a, 4);
            if (part == 0) s_qn[t] = a;
        }
#pragma unroll
        for (int k2 = 0; k2 < 2; ++k2) {
            const int tc = tc0 + k2; const int t = tr * 16 + fr;
            f32x4 a = (f32x4){0.f, 0.f, 0.f, 0.f};
            if (tc <= tr) {
#pragma unroll
                for (int ks = 0; ks < 2; ++ks) a = mfma16(ldfrag(Ks, 72, tc * 16 + fr, ks * 32 + 8 * fq), ldfrag(Qs, 72, t, ks * 32 + 8 * fq), a);
                const float bt = s_bc[t] - s_mt[t];
#pragma unroll
                for (int j = 0; j < 4; ++j) { const int s = tc * 16 + 4 * fq + j; a[j] = (s <= t) ? a[j] * __expf(bt - s_bc[s] + s_ic[s]) : 0.f; }
            }
            float rs = a[0] + a[1] + a[2] + a[3];
            rs += __shfl_xor(rs, 16); rs += __shfl_xor(rs, 32);
            if (fq == 0) s_rsp[tc * 64 + t] = rs;
            u32x2 o; o[0] = pack2(a[0], a[1]); o[1] = pack2(a[2], a[3]);
            *(u32x2*)(Sw + t * 72 + 32 * (tc >> 1) + 8 * fq + 4 * (tc & 1)) = o;
        }
        lds_barrier();
        const float decay = s_sc[0];
        const bf16_t* Cc = Cb + cur * 128 * 72; bf16_t* Cn = Cb + (cur ^ 1) * 128 * 72;
        auto vfrag = [&](int et, int ks) -> bf16x8 {
            const bf16_t* base = VT + (32 * ks + 4 * fq + (fr >> 2)) * 136 + 16 * et + 4 * (fr & 3);
            const s16x4 lo = __builtin_amdgcn_ds_read_tr16_b64_v4i16((LAS s16x4*)(LAS unsigned char*)(unsigned char*)base);
            const s16x4 hi = __builtin_amdgcn_ds_read_tr16_b64_v4i16((LAS s16x4*)(LAS unsigned char*)(unsigned char*)(base + 16 * 136));
            return __builtin_shufflevector(lo, hi, 0, 1, 2, 3, 4, 5, 6, 7);
        };
        const int ec0 = (wid & 1) * 4;
        {
            const int t = tr * 16 + fr;
            const float wi = s_wi[t];
            const float den = s_rsp[t] + s_rsp[64 + t] + s_rsp[128 + t] + s_rsp[192 + t] + wi * s_qn[t];
            const float dn = 1.f / fmaxf(fabsf(den), __expf(-s_mt[t]));
#pragma unroll
            for (int k4 = 0; k4 < 4; ++k4) {
                const int tc = ec0 + k4;
                f32x4 a1 = (f32x4){0.f, 0.f, 0.f, 0.f}, a2 = (f32x4){0.f, 0.f, 0.f, 0.f};
#pragma unroll
                for (int ks = 0; ks < 2; ++ks) {
                    a1 = mfma16(vfrag(tc, ks), ldfrag(Sw, 72, t, ks * 32 + 8 * fq), a1);
                    a2 = mfma16(ldfrag(Cc, 72, tc * 16 + fr, ks * 32 + 8 * fq), ldfrag(Qs, 72, t, ks * 32 + 8 * fq), a2);
                }
                u32x2 o; o[0] = pack2((a1[0] + wi * a2[0]) * dn, (a1[1] + wi * a2[1]) * dn); o[1] = pack2((a1[2] + wi * a2[2]) * dn, (a1[3] + wi * a2[3]) * dn);
                *(u32x2*)(MO + (size_t)pos_row(r0, t) * 512 + h * 128 + tc * 16 + 4 * fq) = o;
            }
        }
#pragma unroll
        for (int k4 = 0; k4 < 4; ++k4) {
            const int tc = ec0 + k4;
            f32x4 a = Cacc[k4] * decay;
#pragma unroll
            for (int ks = 0; ks < 2; ++ks) a = mfma16(ldfrag(KwT, 72, tr * 16 + fr, ks * 32 + 8 * fq), vfrag(tc, ks), a);
            Cacc[k4] = a;
            u32x2 o; o[0] = pack2(a[0], a[1]); o[1] = pack2(a[2], a[3]);
            *(u32x2*)(Cn + (tc * 16 + fr) * 72 + tr * 16 + 4 * fq) = o;
        }
        {
            const int d = tid >> 3, part = tid & 7; float a = 0.f;
#pragma unroll
            for (int j = 0; j < 8; ++j) { const int s = part * 8 + j; a += s_wk[s] * bf2f(Ks[s * 72 + d]); }
            a += __shfl_xor(a, 1); a += __shfl_xor(a, 2); a += __shfl_xor(a, 4);
            if (part == 0) s_nv[d] = decay * s_nv[d] + a;
        }
        cur ^= 1;
    }
    lds_barrier();
}

DI void phase_a0(const Params& p, unsigned char* smem, int rep) {
    __shared__ int s_item;
    float l1 = 0.f, l2 = 0.f;
    for (int i = 0; i < 64; ++i) { l1 += p.diff_lambda[i] * p.diff_lambda[64 + i]; l2 += p.diff_lambda[128 + i] * p.diff_lambda[192 + i]; }
    const float lam = expf(l1) - expf(l2) + 0.2f;
    #ifdef A0_MODE
    if (rep == 0 || (A0_MODE & 1))
#endif
    { const int bb = bid_op(); if (bb < 64) mlstm_scan(p, bb, smem); }
#ifdef A0_MODE
    if (rep == 1 && !(A0_MODE & 2)) return;
#endif
    unsigned* ctr = (unsigned*)(p.ws + WS_CTL) + 3584 + 1024 * rep;
    const unsigned myx = ((unsigned)__builtin_amdgcn_s_getreg((3 << 11) | 20)) & 7u;
    for (unsigned k = 0; k < 8; ++k) {
        const unsigned x = (myx + k) & 7u;
        for (;;) {
            __syncthreads();
            if (tid_op() == 0) s_item = (int)atomicAdd(ctr + 64 * x, 1u);
            __syncthreads();
            const int j = s_item;
            if (j >= 136) break;
            const int G = (int)x * 4 + j / 34, r = j % 34;
            const int item = r < 32 ? G * 32 + r : 1024 + G * 2 + (r - 32);
            attn_item(p, item, smem, lam);
        }
    }
}

DI void phase_m0(const Params& p) {
    const int tid = tid_op(); const int lane = tid & 63, gw = bid_op() * 8 + (tid >> 6), nw = gridDim.x * 8;
    const bf16_t* P = (const bf16_t*)(p.ws + WS_PH);
    const bf16_t* MF = (const bf16_t*)(p.ws + WS_SC) + (size_t)T * 512; const bf16_t* MB = MF + (size_t)T * 512;
    bf16_t* HB = (bf16_t*)(p.ws + WS_HB);
    for (int row = gw; row < T; row += nw) {
        const int c0 = lane * 8;
        const u32x4 a = *(const u32x4*)(MF + (size_t)row * 512 + c0), bb = *(const u32x4*)(MB + (size_t)row * 512 + c0);
        const u32x4 op = *(const u32x4*)(P + (size_t)row * PLD + 2560 + c0);
        float v[8]; float ss = 0.f;
#pragma unroll
        for (int j = 0; j < 4; ++j) {
            v[2 * j] = bf2f((bf16_t)(a[j] & 0xffffu)) + bf2f((bf16_t)(bb[j] & 0xffffu)); v[2 * j + 1] = bf2f((bf16_t)(a[j] >> 16)) + bf2f((bf16_t)(bb[j] >> 16));
            ss += v[2 * j] * v[2 * j] + v[2 * j + 1] * v[2 * j + 1];
        }
        ss += __shfl_xor(ss, 1); ss += __shfl_xor(ss, 2); ss += __shfl_xor(ss, 4); ss += __shfl_xor(ss, 8);
        const float rstd = rsqrtf(ss * (1.f / 128.f) + EPS);
        u32x4 o;
#pragma unroll
        for (int j = 0; j < 4; ++j) {
            const float o0 = v[2 * j] * rstd * p.ml_norm_g[c0 + 2 * j] * sigmoidf(bf2f((bf16_t)(op[j] & 0xffffu)));
            const float o1 = v[2 * j + 1] * rstd * p.ml_norm_g[c0 + 2 * j + 1] * sigmoidf(bf2f((bf16_t)(op[j] >> 16)));
            o[j] = pack2(o0, o1);
        }
        *(u32x4*)(HB + (size_t)row * D + 512 + c0) = o;
    }
}

DI void phase_e1(const Params& p, unsigned char* smem) {
    const int tid = tid_op();
    const bf16_t* P = (const bf16_t*)(p.ws + WS_PH);
    bf16_t* LA = (bf16_t*)(p.ws + WS_HB);
    float* lrs = (float*)smem;
    const int c2 = (tid & 255) * 2, rh = tid >> 8;
    float wf[16][2], wb[16][2];
#pragma unroll
    for (int r = 0; r < 16; ++r) { wf[r][0] = p.gla_w_gate[r * 512 + c2]; wf[r][1] = p.gla_w_gate[r * 512 + c2 + 1]; wb[r][0] = p.gla_w_gate[(16 + r) * 512 + c2]; wb[r][1] = p.gla_w_gate[(16 + r) * 512 + c2 + 1]; }
    const float bf0 = p.gla_b_gate[c2], bf1 = p.gla_b_gate[c2 + 1], bb0 = p.gla_b_gate[512 + c2], bb1 = p.gla_b_gate[512 + c2 + 1];
    for (int chunk = bid_op(); chunk < T / 16; chunk += gridDim.x) {
        const int row0 = chunk * 16;
        __syncthreads();
        if (tid < 128) { const int rr = tid >> 3, c4 = (tid & 7) * 4;
          const u32x2 v = *(const u32x2*)(P + (size_t)(row0 + rr) * PLD + 3072 + c4);
          lrs[rr * 32 + c4] = bf2f((bf16_t)(v[0] & 0xffffu)); lrs[rr * 32 + c4 + 1] = bf2f((bf16_t)(v[0] >> 16)); lrs[rr * 32 + c4 + 2] = bf2f((bf16_t)(v[1] & 0xffffu)); lrs[rr * 32 + c4 + 3] = bf2f((bf16_t)(v[1] >> 16)); }
        __syncthreads();
#pragma unroll 2
        for (int it = 0; it < 8; ++it) {
            const int i = 2 * it + rh;
            float zf0 = bf0, zf1 = bf1, zb0 = bb0, zb1 = bb1;
#pragma unroll
            for (int r = 0; r < 16; ++r) { const float a = lrs[i * 32 + r], b = lrs[i * 32 + 16 + r]; zf0 += a * wf[r][0]; zf1 += a * wf[r][1]; zb0 += b * wb[r][0]; zb1 += b * wb[r][1]; }
            *(unsigned*)(LA + (size_t)(row0 + i) * 512 + c2) = pack2(logsigf(zf0) * (1.f / 16.f), logsigf(zf1) * (1.f / 16.f));
            *(unsigned*)(LA + (size_t)T * 512 + (size_t)(row0 + i) * 512 + c2) = pack2(logsigf(zb0) * (1.f / 16.f), logsigf(zb1) * (1.f / 16.f));
        }
    }
}

DI void phase_s1(const Params& p, unsigned char* smem) {
    const int tid = tid_op(), wid = tid >> 6, lane = tid & 63, fr = lane & 15, fq = lane >> 4;
    const bf16_t* P = (const bf16_t*)(p.ws + WS_PH);
    bf16_t* Qe = (bf16_t*)smem;
    bf16_t* Ke = Qe + 64 * 136;
    bf16_t* LAs = Ke + 64 * 136;
    bf16_t* KdT = LAs + 64 * 144;
    bf16_t* VT = KdT + 128 * 72;
    bf16_t* Am = VT + 64 * 72;
    bf16_t* St = Am + 64 * 72;
    float* s_bl = (float*)(St + 2 * 64 * 136);
    for (int sb = bid_op(); sb < 256; sb += gridDim.x) {
        const int b = sb >> 5, h = (sb >> 3) & 3, dir = (sb >> 2) & 1, es = sb & 3;
        const bf16_t* LA = (const bf16_t*)(p.ws + WS_HB) + (size_t)dir * T * 512;
        bf16_t* OO = (bf16_t*)(p.ws + WS_SC) + (size_t)dir * T * D;
        lds_barrier();
        for (int i = tid; i < 2 * 64 * 136; i += NTHREADS) St[i] = 0;
        f32x4 Sacc[4];
#pragma unroll
        for (int k = 0; k < 4; ++k) Sacc[k] = (f32x4){0.f, 0.f, 0.f, 0.f};
        auto chunk_row0 = [&](int ci) -> int { return ci < 4 ? b * CTXL + (dir ? 3 - ci : ci) * 64 : TCTX + b * SEQ + (dir ? 63 - (ci - 4) : ci - 4) * 64; };
        auto pos_row = [&](int r0, int i) -> int { return r0 + (dir ? 63 - i : i); };
        const int pr[2] = {tid >> 4, (tid >> 4) + 32}; const int pc = (tid & 15) * 8; const int vr = tid >> 3, vc = (tid & 7) * 8;
        u32x4 qA[2], kA[2], lA[2], vA, qB[2], kB[2], lB[2], vB;
        auto prefetch = [&](int ci, u32x4 (&qreg)[2], u32x4 (&kreg)[2], u32x4 (&lreg)[2], u32x4& vreg) {
            const int r0p = chunk_row0(ci);
#pragma unroll
            for (int i = 0; i < 2; ++i) {
                const size_t row = (size_t)pos_row(r0p, pr[i]);
                qreg[i] = *(const u32x4*)(P + row * PLD + h * 128 + pc);
                kreg[i] = *(const u32x4*)(P + row * PLD + 512 + h * 128 + pc);
                lreg[i] = *(const u32x4*)(LA + row * 512 + h * 128 + pc);
            }
            vreg = *(const u32x4*)(P + (size_t)pos_row(r0p, vr) * PLD + 1024 + h * 256 + es * 64 + vc);
        };
        prefetch(0, qA, kA, lA, vA);
        int cur = 0;
        auto step = [&](int ci, u32x4 (&qreg)[2], u32x4 (&kreg)[2], u32x4 (&lreg)[2], u32x4& vreg, u32x4 (&qn)[2], u32x4 (&kn)[2], u32x4 (&ln)[2], u32x4& vn) {
            const int r0 = chunk_row0(ci);
            lds_barrier();
            if (ci + 1 < 68) prefetch(ci + 1, qn, kn, ln, vn);
#pragma unroll
            for (int i = 0; i < 2; ++i) {
                *(u32x4*)(Qe + pr[i] * 136 + pc) = qreg[i];
                *(u32x4*)(Ke + pr[i] * 136 + pc) = kreg[i];
                *(u32x4*)(LAs + pr[i] * 144 + pc) = lreg[i];
            }
            *(u32x4*)(VT + vr * 72 + vc) = vreg;
            lds_barrier();
            {
                bf16x8 laf[2];
#pragma unroll
                for (int ks = 0; ks < 2; ++ks) {
                    const bf16_t* base = LAs + (32 * ks + 4 * fq + (fr >> 2)) * 144 + 16 * wid + 4 * (fr & 3);
                    const s16x4 lo = __builtin_amdgcn_ds_read_tr16_b64_v4i16((LAS s16x4*)(LAS unsigned char*)(unsigned char*)base);
                    const s16x4 hi = __builtin_amdgcn_ds_read_tr16_b64_v4i16((LAS s16x4*)(LAS unsigned char*)(unsigned char*)(base + 16 * 144));
                    laf[ks] = __builtin_shufflevector(lo, hi, 0, 1, 2, 3, 4, 5, 6, 7);
                }
                const bf16x8 ones = (bf16x8){0x3F80, 0x3F80, 0x3F80, 0x3F80, 0x3F80, 0x3F80, 0x3F80, 0x3F80};
                f32x4 blt = (f32x4){0.f, 0.f, 0.f, 0.f};
#pragma unroll
                for (int ks = 0; ks < 2; ++ks) blt = mfma16(laf[ks], ones, blt);
                float ebl[4];
#pragma unroll
                for (int j = 0; j < 4; ++j) ebl[j] = __expf(blt[j]);
                if (fr == 0) { *(f32x4*)(s_bl + 16 * wid + 4 * fq) = blt; }
#pragma unroll
                for (int ti = 0; ti < 4; ++ti) {
                    const int i = 16 * ti + fr;
                    const int islot = 32 * (i >> 5) + 8 * ((i >> 2) & 3) + 4 * ((i >> 4) & 1) + (i & 3);
                    f32x4 bc = (f32x4){0.f, 0.f, 0.f, 0.f};
#pragma unroll
                    for (int ks = 0; ks < 2; ++ks) {
                        bf16x8 tri;
#pragma unroll
                        for (int e = 0; e < 8; ++e) { const int jpos = 32 * ks + 16 * (e >> 2) + 4 * fq + (e & 3); tri[e] = (jpos <= i) ? (short)0x3F80 : (short)0; }
                        bc = mfma16(laf[ks], tri, bc);
                    }
                    const int d0 = 16 * wid + 4 * fq;
                    const u32x2 qv = *(const u32x2*)(Qe + i * 136 + d0), kv = *(const u32x2*)(Ke + i * 136 + d0);
                    float qf[4] = {bf2f((bf16_t)(qv[0] & 0xffffu)), bf2f((bf16_t)(qv[0] >> 16)), bf2f((bf16_t)(qv[1] & 0xffffu)), bf2f((bf16_t)(qv[1] >> 16))};
                    float kf[4] = {bf2f((bf16_t)(kv[0] & 0xffffu)), bf2f((bf16_t)(kv[0] >> 16)), bf2f((bf16_t)(kv[1] & 0xffffu)), bf2f((bf16_t)(kv[1] >> 16))};
                    float qo[4], ko[4];
#pragma unroll
                    for (int j = 0; j < 4; ++j) {
                        const float E = __expf(bc[j]), R = __expf(-bc[j]);
                        qo[j] = qf[j] * 0.08838834764831845f * E; ko[j] = kf[j] * R;
                        KdT[(d0 + j) * 72 + islot] = f2bf(ko[j] * ebl[j]);
                    }
                    u32x2 qw, kw; qw[0] = pack2(qo[0], qo[1]); qw[1] = pack2(qo[2], qo[3]); kw[0] = pack2(ko[0], ko[1]); kw[1] = pack2(ko[2], ko[3]);
                    *(u32x2*)(Qe + i * 136 + d0) = qw; *(u32x2*)(Ke + i * 136 + d0) = kw;
                }
            }
            lds_barrier();
            const int tr = wid >> 1, tc0 = (wid & 1) * 2;
#pragma unroll
            for (int k2 = 0; k2 < 2; ++k2) {
                const int tc = tc0 + k2; const int t = tr * 16 + fr;
                f32x4 a = (f32x4){0.f, 0.f, 0.f, 0.f};
                if (tc <= tr) {
#pragma unroll
                    for (int ks = 0; ks < 4; ++ks) a = mfma16(ldfrag(Ke, 136, tc * 16 + fr, ks * 32 + 8 * fq), ldfrag(Qe, 136, t, ks * 32 + 8 * fq), a);
#pragma unroll
                    for (int j = 0; j < 4; ++j) { const int sp = tc * 16 + 4 * fq + j; if (sp > t) a[j] = 0.f; }
                }
                u32x2 o; o[0] = pack2(a[0], a[1]); o[1] = pack2(a[2], a[3]);
                *(u32x2*)(Am + t * 72 + 32 * (tc >> 1) + 8 * fq + 4 * (tc & 1)) = o;
            }
            lds_barrier();
            const bf16_t* Sc = St + cur * 64 * 136; bf16_t* Sn = St + (cur ^ 1) * 64 * 136;
            auto vfrag = [&](int et, int ks) -> bf16x8 {
                const bf16_t* base = VT + (32 * ks + 4 * fq + (fr >> 2)) * 72 + 16 * et + 4 * (fr & 3);
                const s16x4 lo = __builtin_amdgcn_ds_read_tr16_b64_v4i16((LAS s16x4*)(LAS unsigned char*)(unsigned char*)base);
                const s16x4 hi = __builtin_amdgcn_ds_read_tr16_b64_v4i16((LAS s16x4*)(LAS unsigned char*)(unsigned char*)(base + 16 * 72));
                return __builtin_shufflevector(lo, hi, 0, 1, 2, 3, 4, 5, 6, 7);
            };
            if (ci >= 4) {
#pragma unroll
                for (int k2 = 0; k2 < 2; ++k2) {
                    const int tc = tc0 + k2; const int t = tr * 16 + fr;
                    f32x4 a = (f32x4){0.f, 0.f, 0.f, 0.f};
#pragma unroll
                    for (int ks = 0; ks < 2; ++ks) a = mfma16(vfrag(tc, ks), ldfrag(Am, 72, t, ks * 32 + 8 * fq), a);
#pragma unroll
                    for (int ks = 0; ks < 4; ++ks) a = mfma16(ldfrag(Sc, 136, tc * 16 + fr, ks * 32 + 8 * fq), ldfrag(Qe, 136, t, ks * 32 + 8 * fq), a);
                    u32x2 o; o[0] = pack2(a[0], a[1]); o[1] = pack2(a[2], a[3]);
                    *(u32x2*)(OO + (size_t)pos_row(r0, t) * D + h * 256 + es * 64 + tc * 16 + 4 * fq) = o;
                }
            }
#pragma unroll
            for (int et = 0; et < 4; ++et) {
                f32x4 a = Sacc[et];
#pragma unroll
                for (int j = 0; j < 4; ++j) a[j] *= __expf(s_bl[wid * 16 + 4 * fq + j]);
#pragma unroll
                for (int ks = 0; ks < 2; ++ks) a = mfma16(ldfrag(KdT, 72, wid * 16 + fr, ks * 32 + 8 * fq), vfrag(et, ks), a);
                Sacc[et] = a;
                u32x2 o; o[0] = pack2(a[0], a[1]); o[1] = pack2(a[2], a[3]);
                *(u32x2*)(Sn + (et * 16 + fr) * 136 + wid * 16 + 4 * fq) = o;
            }
            cur ^= 1;
        };
        for (int ci = 0; ci < 68; ci += 2) { step(ci, qA, kA, lA, vA, qB, kB, lB, vB); step(ci + 1, qB, kB, lB, vB, qA, kA, lA, vA); }
    }
    lds_barrier();
}

DI void phase_m1(const Params& p) {
    const int tid = tid_op(); const int lane = tid & 63, gw = bid_op() * 8 + (tid >> 6), nw = gridDim.x * 8;
    const bf16_t* P = (const bf16_t*)(p.ws + WS_PH);
    const bf16_t* OF = (const bf16_t*)(p.ws + WS_SC); const bf16_t* OB = OF + (size_t)T * D;
    bf16_t* HB = (bf16_t*)(p.ws + WS_HB);
    for (int row = TCTX + gw; row < T; row += nw) {
        const int c0 = lane * 16;
        float v[16]; float ss = 0.f;
#pragma unroll
        for (int hlf = 0; hlf < 2; ++hlf) {
            const u32x4 a = *(const u32x4*)(OF + (size_t)row * D + c0 + hlf * 8), bb = *(const u32x4*)(OB + (size_t)row * D + c0 + hlf * 8);
#pragma unroll
            for (int j = 0; j < 4; ++j) {
                const float x0 = bf2f((bf16_t)(a[j] & 0xffffu)) + bf2f((bf16_t)(bb[j] & 0xffffu)), x1 = bf2f((bf16_t)(a[j] >> 16)) + bf2f((bf16_t)(bb[j] >> 16));
                v[hlf * 8 + 2 * j] = x0; v[hlf * 8 + 2 * j + 1] = x1; ss += x0 * x0 + x1 * x1;
            }
        }
        ss += __shfl_xor(ss, 1); ss += __shfl_xor(ss, 2); ss += __shfl_xor(ss, 4); ss += __shfl_xor(ss, 8);
        const float rstd = rsqrtf(ss * (1.f / 256.f) + EPS);
        const int gc = c0 & 255;
#pragma unroll
        for (int hlf = 0; hlf < 2; ++hlf) {
            const u32x4 rr = *(const u32x4*)(P + (size_t)row * PLD + 2048 + c0 + hlf * 8);
            u32x4 o;
#pragma unroll
            for (int j = 0; j < 4; ++j) {
                const float r0 = bf2f((bf16_t)(rr[j] & 0xffffu)), r1 = bf2f((bf16_t)(rr[j] >> 16));
                o[j] = pack2(v[hlf * 8 + 2 * j] * rstd * p.gla_norm_g[gc + hlf * 8 + 2 * j] * siluf(r0), v[hlf * 8 + 2 * j + 1] * rstd * p.gla_norm_g[gc + hlf * 8 + 2 * j + 1] * siluf(r1));
            }
            *(u32x4*)(HB + (size_t)row * D + c0 + hlf * 8) = o;
        }
    }
}

#define XB_TMO      128
#define XB_XCNT(j)  (256  + 64 * (j))
#define XB_XSUB(j)  (1280 + 64 * (j))
#define XB_XGEN(j)  (2304 + 64 * (j))
#define XB_TOP      3328
#define XB_TOPGEN   3392
#define XCD_BAR_WORDS 3456
#define XB_SPIN_CAP (1u << 18)
DI unsigned xb_ld(unsigned* p) { return __hip_atomic_load(p, __ATOMIC_RELAXED, __HIP_MEMORY_SCOPE_AGENT); }
DI unsigned xb_add(unsigned* p, unsigned v) { return __hip_atomic_fetch_add(p, v, __ATOMIC_RELAXED, __HIP_MEMORY_SCOPE_AGENT); }
DI unsigned xb_xcc_id() { return (unsigned)__builtin_amdgcn_s_getreg((3 << 11) | 20) & 0xFu; }
#define XB_SPIN(cond, bar) do { unsigned _sp = 0; while (cond) { __builtin_amdgcn_s_sleep(1); \
    if ((++_sp & 255u) == 0u) { if (xb_ld(&(bar)[XB_TMO])) break; if (_sp > XB_SPIN_CAP) { atomicAdd(&(bar)[XB_TMO], 1u); break; } } } } while (0)
struct XcdBarrier { unsigned* bar; unsigned x; volatile LAS unsigned* st; };
DI XcdBarrier xcd_barrier_post(unsigned* bar, volatile LAS unsigned* st) {
    XcdBarrier b; b.bar = bar; b.x = xb_xcc_id(); b.st = st;
    if (threadIdx.x == 0) (void)xb_add(&bar[XB_XCNT(b.x)], 1u);
    return b;
}
DI void xcd_barrier_complete(unsigned* bar, unsigned x, unsigned& nloc, unsigned& nx) {
    const unsigned G = gridDim.x * gridDim.y * gridDim.z;
    unsigned sum, cnt, mine, sp = 0u;
    for (;;) {
        sum = 0u; cnt = 0u; mine = 0u;
#pragma unroll
        for (unsigned j = 0; j < 16; ++j) { const unsigned c = xb_ld(&bar[XB_XCNT(j)]); sum += c; cnt += (c > 0u) ? 1u : 0u; mine = (j == x) ? c : mine; }
        if (sum == G) break;
        __builtin_amdgcn_s_sleep(1);
        if ((++sp & 255u) == 0u) { if (xb_ld(&bar[XB_TMO])) break; if (sp > XB_SPIN_CAP) { atomicAdd(&bar[XB_TMO], 1u); break; } }
    }
    nloc = mine > 0u ? mine : 1u; nx = cnt > 0u ? cnt : 1u;
}
DI void xcd_barrier(unsigned* bar_, unsigned char* smem_) {
    asm volatile("s_waitcnt vmcnt(0)" ::: "memory");
    __syncthreads();
    if (threadIdx.x == 0) {
        XcdBarrier b; b.bar = bar_; b.x = xb_xcc_id(); b.st = (volatile LAS unsigned*)(LAS unsigned char*)(smem_ + LDS_BYTES - 16);
        unsigned* bar = b.bar;
        __builtin_amdgcn_s_waitcnt(0);
        unsigned nloc = b.st[0], nx = b.st[1];
        if (nloc == 0u) { xcd_barrier_complete(bar, b.x, nloc, nx); b.st[0] = nloc; b.st[1] = nx; }
        const unsigned old = xb_add(&bar[XB_XSUB(b.x)], 1u);
        const unsigned gen = old / nloc;
        if (old + 1u == (gen + 1u) * nloc) {
            __builtin_amdgcn_fence(__ATOMIC_RELEASE, "agent");
            asm volatile("s_waitcnt vmcnt(0)" ::: "memory");
            const unsigned og = xb_add(&bar[XB_TOP], 1u);
            const unsigned tg = og / nx;
            if (og + 1u == (tg + 1u) * nx) xb_add(&bar[XB_TOPGEN], 1u);
            else XB_SPIN(xb_ld(&bar[XB_TOPGEN]) == tg, bar);
            __builtin_amdgcn_fence(__ATOMIC_ACQUIRE, "agent");
            xb_add(&bar[XB_XGEN(b.x)], 1u);
            asm volatile("s_waitcnt vmcnt(0)" ::: "memory");
        } else {
            XB_SPIN(xb_ld(&bar[XB_XGEN(b.x)]) == gen, bar);
            __builtin_amdgcn_fence(__ATOMIC_ACQUIRE, "agent");
            asm volatile("s_waitcnt vmcnt(0)" ::: "memory");
        }
    }
    __syncthreads();
}

constexpr int N_PHASES = 26;
#ifndef PH_MASK
#define PH_MASK 0xFFFFu
#endif
#define PH_ON(k) ((PH_MASK >> (k)) & 1u)
DI void run_phase(const Params& p, int ph, unsigned char* smem, int rep) {
    bf16_t* HB = (bf16_t*)(p.ws + WS_HB);
    bf16_t* PH = (bf16_t*)(p.ws + WS_PH);
    float* XC = (float*)(p.ws + WS_XC);
    if (ph == 0) { if (PH_ON(0)) phase_prep(p, smem); return; }
    if (ph == 25) { if (PH_ON(11)) phase_final(p.out, p.final_g); return; }
    const int l = (ph - 1) / 12, s = (ph - 1) % 12;
    const float* mods_l = (const float*)(p.ws + WS_MODS) + (size_t)l * 9 * NMOD;
    const bool first = (l == 0 && s <= 2);
    const float* src_ctx = first ? p.ctx : XC; const float* src_lat = first ? p.x : p.out;
    const int lat_only = (l == 1 && s >= 8) ? 1 : 0;
    const int row_lo = lat_only ? TCTX : 0;
    g8::StaticOrder S;
    LAS unsigned char* lds = (LAS unsigned char*)smem;
    switch (s) {
    case 0: case 3: case 9: if (PH_ON(1)) {
        const bool pend = (s == 3) || (s == 9 && l == 0) || (s == 0 && l == 1);
        const int nsl = s == 9 ? 4 : 8;
        phase_norm((s == 0 && l == 0) ? p.ctx : XC, (s == 0 && l == 0) ? p.x : p.out, HB, mods_l, p.norm_g + (size_t)(l * 3 + (s == 0 ? 0 : (s == 3 ? 1 : 2))) * D, s == 0 ? 0 : (s == 3 ? 3 : 6), s == 9 ? row_lo : 0,
                   pend ? (const bf16_t*)(p.ws + WS_SC) : nullptr, nsl, XC);
    } break;

    case 1: case 10: if (PH_ON(2)) {
        const int f = s == 1 ? 0 : 1;
        g8::Gemm g{HB + (size_t)row_lo * D, (const bf16_t*)(p.ws + WS_WFI + (size_t)(l * 2 + f) * SZ_WFI), T - row_lo, NFF, D, D};
        S.init(g.M, g.N, gridDim.x, bid_op());
        g8::EpiSwiglu E{PH, row_lo};
        g8::gemm_phase(lds, g, S, E);
    } break;
    case 2: case 11: case 8: if (PH_ON(3)) {
        const bf16_t* Ab; const bf16_t* Wb; int K; int gate_idx; float coef;
        if (s == 8) { Ab = HB; Wb = (const bf16_t*)(p.ws + WS_WMO + (size_t)l * SZ_WMO); K = D; gate_idx = 5; coef = 1.0f; }
        else { const int f = s == 2 ? 0 : 1; Ab = PH; Wb = (const bf16_t*)(p.ws + WS_WFO + (size_t)(l * 2 + f) * SZ_WFO); K = DFF; gate_idx = f == 0 ? 2 : 8; coef = 0.5f; }
        {
            g8::Gemm g{Ab + (size_t)TCTX * K, Wb, TLAT, D, K, K};
            g8::EpiResid E;
            E.src_ctx = src_ctx; E.src_lat = src_lat; E.dst_ctx = XC; E.dst_lat = p.out; E.mods = mods_l; E.row_base = TCTX; E.gate_idx = gate_idx; E.coef = coef;
            S.init(g.M, g.N, gridDim.x, bid_op());
            g8::gemm_phase(lds, g, S, E);
        }
        if (!lat_only) {
            const int nsl = K == D ? 4 : 8, nitems = 32 * nsl;
            for (int item = bid_op(); item < nitems; item += gridDim.x) {
                const int u = item / nsl, sl = item % nsl;
                int k0, kl;
                if (K == D) { k0 = sl * 256; kl = 256; } else if (sl < 6) { k0 = sl * 384; kl = 384; } else { k0 = 2304 + (sl - 6) * 256; kl = 256; }
                g8::Gemm g{Ab + k0, Wb + k0, TCTX, D, kl, K};
                g8::SingleUnit SU; SU.u.pm = u >> 2; SU.u.pn = u & 3;
                g8::EpiPartial E{(bf16_t*)(p.ws + WS_SC) + (size_t)sl * TCTX * D, mods_l + (size_t)8 * NMOD + gate_idx * D, coef};
                g8::gemm_phase(lds, g, SU, E);
            }
        }
    } break;
    case 4: if (PH_ON(4)) {
        g8::Gemm g{HB, (const bf16_t*)(p.ws + WS_WMI + (size_t)l * SZ_WMI), T, PN, D, D};
        S.init(g.M, g.N, gridDim.x, bid_op());
        g8::EpiP E{PH, l == 0 ? (float*)(p.ws + WS_GATES) : nullptr, p.gate_b};
        g8::gemm_phase(lds, g, S, E);
    } break;
    case 5: if (l == 0) { if (PH_ON(5)) phase_e0(p, smem); } else { if (PH_ON(6)) phase_e1(p, smem); } break;
    case 6: if (l == 0) { if (PH_ON(7)) phase_a0(p, smem, rep); } else { if (PH_ON(8)) phase_s1(p, smem); } break;
    case 7: if (l == 0) { if (PH_ON(9)) phase_m0(p); } else { if (PH_ON(10)) phase_m1(p); } break;
    }
}

__global__ void __launch_bounds__(NTHREADS, 2) fwd_kernel(Params p) {
    extern __shared__ __attribute__((aligned(16))) unsigned char smem[];
    if (p.coop) {
        volatile LAS unsigned* st = (volatile LAS unsigned*)(LAS unsigned char*)(smem + LDS_BYTES - 16);
        if (threadIdx.x == 0) { st[0] = 0u; st[1] = 0u; }
        __syncthreads();
        (void)xcd_barrier_post((unsigned*)(p.ws + WS_CTL), st);
    }
    for (int ph = p.ph_lo; ph < p.ph_hi; ++ph) {
        run_phase(p, ph, smem, 0);
#ifdef DUP_SYNC
        if (ph == 1) { for (int k = 0; k < 20; ++k) xcd_barrier((unsigned*)(p.ws + WS_CTL), smem); }
#endif
#ifdef DUP_PHASE
        if (ph == DUP_PHASE) { cg::this_grid().sync(); run_phase(p, ph, smem, 1); }
#endif
        if (p.coop && ph + 1 < p.ph_hi) {
            if (p.pad == 0x7fffffff) cg::this_grid().sync();
            xcd_barrier((unsigned*)(p.ws + WS_CTL), smem);
        }
    }
}

extern "C" void kernel_launch(void* const* d_in, const int* in_sizes, int n_in, void* d_out, int out_size, void* d_ws, size_t ws_size, hipStream_t stream) {
    static int grid = 0;
    if (grid == 0) {
        if (n_in != 23 || ws_size < WS_END) { fprintf(stderr, "kernel_launch: unexpected n_in %d or workspace %zu < %zu\n", n_in, ws_size, (size_t)WS_END); grid = -1; return; }
        int dev = 0, cus = 0, per_cu = 0;
        hipGetDevice(&dev);
        hipDeviceGetAttribute(&cus, hipDeviceAttributeMultiprocessorCount, dev);
        if (hipFuncSetAttribute((const void*)fwd_kernel, hipFuncAttributeMaxDynamicSharedMemorySize, LDS_BYTES) != hipSuccess) { fprintf(stderr, "kernel_launch: hipFuncSetAttribute failed\n"); grid = -1; return; }
        hipOccupancyMaxActiveBlocksPerMultiprocessor(&per_cu, (const void*)fwd_kernel, NTHREADS, LDS_BYTES);
        if (per_cu < 1) per_cu = 1;
        grid = cus * per_cu;
        (void)hipGetLastError();
    }
    if (grid < 0) return;
    (void)hipMemsetAsync((char*)d_ws + WS_CTL, 0, 16384, stream);
    Params p{};
    const float** pp = (const float**)&p;
    for (int i = 0; i < 23; ++i) pp[i] = (const float*)d_in[i];
    p.out = (float*)d_out; p.ws = (unsigned char*)d_ws;
#if ONE_LAUNCH
    p.ph_lo = 0; p.ph_hi = N_PHASES; p.coop = 1;
    void* args[] = {&p};
    hipError_t e = hipLaunchCooperativeKernel((const void*)fwd_kernel, dim3(grid), dim3(NTHREADS), args, LDS_BYTES, stream);
    if (e != hipSuccess) fprintf(stderr, "cooperative launch failed: %s (grid %d)\n", hipGetErrorString(e), grid);
#else
    for (int ph = 0; ph < N_PHASES; ++ph) {
        p.ph_lo = ph; p.ph_hi = ph + 1; p.coop = 0;
        hipLaunchKernelGGL(fwd_kernel, dim3(grid), dim3(NTHREADS), LDS_BYTES, stream, p);
    }
#endif
}
```
